# Optimizing an MI355X kernel written in HIP

```python
import jax, jax.numpy as jnp
from jax import lax
import numpy as np

D_MODEL = 1024
BATCH = 8
SEQ = 8192
DEPTH = 2
DEC_BATCH = 2
DEC_SEQ = 16384
PAST_LEN = 128

N_EVEN = (DEPTH + 1) // 2
N_ODD = DEPTH // 2
D_A = 512
D_B = 512
K_A = 3
K_B = 31
D_C = 768
H_C = 6
DH_C = D_C // H_C
CHUNK = 128
D_D = 256
G_D = 4
DG_D = D_D // G_D
D_FF = ((8 * D_MODEL // 3 + 255) // 256) * 256
N_MOD = 6
EPS = 1e-6

kernel_name = "hybrid_bidir_conv_gmlp_fnet_encoder"


def rmsnorm(x, g):
    x32 = x.astype(jnp.float32)
    y = x32 * lax.rsqrt(jnp.mean(x32 * x32, axis=-1, keepdims=True) + EPS)
    return y.astype(x.dtype) * g


def layernorm(x, g, b):
    x32 = x.astype(jnp.float32)
    mu = jnp.mean(x32, axis=-1, keepdims=True)
    var = jnp.mean(jnp.square(x32 - mu), axis=-1, keepdims=True)
    y = (x32 - mu) * lax.rsqrt(var + EPS)
    return y.astype(x.dtype) * g + b


def depthwise_conv(x, w):
    k, ch = w.shape
    return lax.conv_general_dilated(
        x, w[:, None, :].astype(x.dtype), window_strides=(1,), padding=[(k // 2, k // 2)],
        dimension_numbers=("NWC", "WIO", "NWC"), feature_group_count=ch)


def mixer_ab(h, w_in, conv_a, conv_b_w, conv_b_b, ln_g, ln_b, w_out):
    p = h @ w_in
    a_b, a_c, a_x, b_val, b_gate = jnp.split(
        p, [D_A, 2 * D_A, 3 * D_A, 3 * D_A + D_B], axis=-1)
    y_a = a_b * depthwise_conv(a_c * a_x, conv_a)
    g = b_val * jax.nn.sigmoid(b_gate)
    z = depthwise_conv(g, conv_b_w) + conv_b_b
    y_b = jax.nn.silu(layernorm(z, ln_g, ln_b))
    return jnp.concatenate([y_a, y_b], axis=-1) @ w_out


def mixer_cd(h, w_in, ln_g, ln_b, w_s, b_s, w_out):
    bsz, s, _ = h.shape
    p = h @ w_in
    u, v, f = jnp.split(p, [D_C, 2 * D_C], axis=-1)
    v = layernorm(v, ln_g, ln_b)
    vc = v.reshape(bsz, s // CHUNK, CHUNK, H_C, DH_C)
    sv = jnp.einsum('hpq,bnqhd->bnphd', w_s, vc) + b_s.T[None, None, :, :, None]
    y_c = u * sv.reshape(bsz, s, D_C)
    fg = f.reshape(bsz, s, G_D, DG_D).astype(jnp.float32)
    y_d = jnp.fft.fftn(fg, axes=(1, 3), norm="ortho").real.astype(h.dtype).reshape(bsz, s, D_D)
    return jnp.concatenate([y_c, y_d], axis=-1) @ w_out


def swiglu(h, w_in, w_out):
    gate, up = jnp.split(h @ w_in, 2, axis=-1)
    return (jax.nn.silu(gate) * up) @ w_out


def trunk(x, c, ada_w, ada_b, mix_norm_g, ffn_norm_g,
          ab_w_in, ab_conv_a, ab_conv_b_w, ab_conv_b_b, ab_ln_g, ab_ln_b, ab_w_out,
          cd_w_in, cd_ln_g, cd_ln_b, cd_w_s, cd_b_s, cd_w_out,
          ffn_w_in, ffn_w_out, final_g):
    sc = jax.nn.silu(c)
    for l in range(DEPTH):
        mod = (sc @ ada_w[l] + ada_b[l])[:, None, :]
        sh1, sc1, g1, sh2, sc2, g2 = jnp.split(mod, N_MOD, axis=-1)
        h = rmsnorm(x, mix_norm_g[l]) * (1 + sc1) + sh1
        if l % 2 == 0:
            i = l // 2
            m = mixer_ab(h, ab_w_in[i], ab_conv_a[i], ab_conv_b_w[i], ab_conv_b_b[i],
                         ab_ln_g[i], ab_ln_b[i], ab_w_out[i])
        else:
            i = l // 2
            m = mixer_cd(h, cd_w_in[i], cd_ln_g[i], cd_ln_b[i], cd_w_s[i], cd_b_s[i], cd_w_out[i])
        x = x + g1 * m
        h = rmsnorm(x, ffn_norm_g[l]) * (1 + sc2) + sh2
        x = x + g2 * swiglu(h, ffn_w_in[l], ffn_w_out[l])
    return rmsnorm(x, final_g)


def setup_inputs(seed: int = 0) -> dict:
    key = jax.random.key(seed)
    ks = jax.random.split(key, 32)
    f32 = jnp.float32
    D = D_MODEL

    def nrm(k, shape, scale):
        return jax.random.normal(k, shape, f32) * scale

    return {
        "x_prompt": nrm(ks[0], (BATCH, SEQ, D), 1.0),
        "x_sample": nrm(ks[1], (DEC_BATCH, DEC_SEQ, D), 1.0),
        "c_prompt": nrm(ks[2], (BATCH, D), 1.0),
        "c_sample": nrm(ks[3], (DEC_BATCH, D), 1.0),
        "ada_w": nrm(ks[4], (DEPTH, D, N_MOD * D), D ** -0.5),
        "ada_b": nrm(ks[5], (DEPTH, N_MOD * D), 0.02),
        "mix_norm_g": 1.0 + nrm(ks[6], (DEPTH, D), 0.02),
        "ffn_norm_g": 1.0 + nrm(ks[7], (DEPTH, D), 0.02),
        "ab_w_in": nrm(ks[8], (N_EVEN, D, 3 * D_A + 2 * D_B), D ** -0.5),
        "ab_conv_a": nrm(ks[9], (N_EVEN, K_A, D_A), K_A ** -0.5),
        "ab_conv_b_w": nrm(ks[10], (N_EVEN, K_B, D_B), K_B ** -0.5),
        "ab_conv_b_b": nrm(ks[11], (N_EVEN, D_B), 0.02),
        "ab_ln_g": 1.0 + nrm(ks[12], (N_EVEN, D_B), 0.02),
        "ab_ln_b": nrm(ks[13], (N_EVEN, D_B), 0.02),
        "ab_w_out": nrm(ks[14], (N_EVEN, D_A + D_B, D), (D_A + D_B) ** -0.5),
        "cd_w_in": nrm(ks[15], (N_ODD, D, 2 * D_C + D_D), D ** -0.5),
        "cd_ln_g": 1.0 + nrm(ks[16], (N_ODD, D_C), 0.02),
        "cd_ln_b": nrm(ks[17], (N_ODD, D_C), 0.02),
        "cd_w_s": nrm(ks[18], (N_ODD, H_C, CHUNK, CHUNK), CHUNK ** -0.5),
        "cd_b_s": nrm(ks[19], (N_ODD, H_C, CHUNK), 0.02),
        "cd_w_out": nrm(ks[20], (N_ODD, D_C + D_D, D), (D_C + D_D) ** -0.5),
        "ffn_w_in": nrm(ks[21], (DEPTH, D, 2 * D_FF), D ** -0.5),
        "ffn_w_out": nrm(ks[22], (DEPTH, D_FF, D), D_FF ** -0.5),
        "final_g": 1.0 + nrm(ks[23], (D,), 0.02),
    }


def reference(x_prompt, x_sample, c_prompt, c_sample, ada_w, ada_b, mix_norm_g, ffn_norm_g,
              ab_w_in, ab_conv_a, ab_conv_b_w, ab_conv_b_b, ab_ln_g, ab_ln_b, ab_w_out,
              cd_w_in, cd_ln_g, cd_ln_b, cd_w_s, cd_b_s, cd_w_out,
              ffn_w_in, ffn_w_out, final_g):
    y_prompt = trunk(x_prompt, c_prompt, ada_w, ada_b, mix_norm_g, ffn_norm_g,
                     ab_w_in, ab_conv_a, ab_conv_b_w, ab_conv_b_b, ab_ln_g, ab_ln_b, ab_w_out,
                     cd_w_in, cd_ln_g, cd_ln_b, cd_w_s, cd_b_s, cd_w_out,
                     ffn_w_in, ffn_w_out, final_g)
    y_sample = trunk(x_sample, c_sample, ada_w, ada_b, mix_norm_g, ffn_norm_g,
                     ab_w_in, ab_conv_a, ab_conv_b_w, ab_conv_b_b, ab_ln_g, ab_ln_b, ab_w_out,
                     cd_w_in, cd_ln_g, cd_ln_b, cd_w_s, cd_b_s, cd_w_out,
                     ffn_w_in, ffn_w_out, final_g)
    return (y_prompt, y_sample)
```

```cpp
#include <hip/hip_runtime.h>
#include <hip/hip_cooperative_groups.h>
#include <cstdio>
namespace cg = cooperative_groups;

namespace pg8 {
#define PG8_LAS __attribute__((address_space(3)))
typedef unsigned short bf16_t;
typedef short bf16x8 __attribute__((ext_vector_type(8)));
typedef float f32x4 __attribute__((ext_vector_type(4)));
typedef unsigned u32x4 __attribute__((ext_vector_type(4)));
constexpr int BM = 256, BK = 64, HALF = 128, HTB = HALF * BK * 2  , STAGE_BYTES = 8 * HTB, NXCD = 8, WGM = 8;

__host__ __device__ __forceinline__ int lds_byte(int r, int c) { const int st = (r >> 4) * 2 + (c >> 5), rr = r & 15, cc = c & 31, ob = rr * 64 + cc * 2; return st * 1024 + (ob ^ (((ob >> 9) & 1) << 5)); }
__host__ __device__ __forceinline__ void stage_rc(int b, int& R, int& C) { const int st = b / 1024, sb = b % 1024, swz = sb ^ (((sb >> 9) & 1) << 5); R = (st >> 1) * 16 + swz / 64; C = (st & 1) * 32 + (swz % 64) / 2; }
__host__ __device__ __forceinline__ int perm32(int rho) { const int n = rho >> 4, i = rho & 15; return 8 * (i >> 2) + 4 * n + (i & 3); }

struct Unit { int pm, pn; };
struct Gemm { const bf16_t* A; const bf16_t* Bt; int M, N, K; size_t bseq; };
__device__ __forceinline__ int seq_of_pm(int pm) { return pm < 256 ? (pm >> 5) : 8 + ((pm - 256) >> 6); }

#ifndef XCD_INTERLEAVE
#define XCD_INTERLEAVE 1
#endif
struct StaticOrder {
    int nM, nN, nwg, G, c;
    __host__ __device__ void init(int M, int N, int G_, int c_) { nM = M / BM; nN = N / BM; nwg = nM * nN; G = G_; c = c_; }
    __host__ __device__ bool next(int i, Unit& u) const {
        const long L = (long)i * G + c; if (L >= nwg) return false;
        int wgid = (int)L; { const int q = nwg / NXCD, r = nwg % NXCD, xcd = wgid % NXCD, off = wgid / NXCD; wgid = (xcd < r ? xcd * (q + 1) : r * (q + 1) + (xcd - r) * q) + off; }
        const int nig = WGM * nN; int gid = wgid / nig;
#if XCD_INTERLEAVE
        { const int ng = nM / WGM, per = ng / NXCD;
          if (nM % (WGM * NXCD) == 0 && nwg % NXCD == 0) gid = (gid % per) * NXCD + gid / per; }
#endif
        const int fm = gid * WGM, gsz = (nM - fm) < WGM ? (nM - fm) : WGM;
        u.pm = fm + ((wgid % nig) % gsz); u.pn = (wgid % nig) / gsz; return true;
    }
    __device__ __forceinline__ void a_ready(const Unit&) const {}
    __device__ __forceinline__ void done(const Unit&) const {}
};
__device__ __forceinline__ unsigned cvt_pk_bf16(float lo, float hi) { unsigned r; asm volatile("v_cvt_pk_bf16_f32 %0, %1, %2" : "=v"(r) : "v"(lo), "v"(hi)); return r; }
template <class Epi, class Sched>
__device__ __forceinline__ void gemm_phase(PG8_LAS unsigned char* lds, const Gemm g, const Sched& S, const Epi& E) {
    int tid = threadIdx.x; asm volatile("" : "+v"(tid)); const int wid = __builtin_amdgcn_readfirstlane(tid >> 6), lane = tid & 63, wr = wid >> 2, wc = wid & 3, fr = lane & 15, fq = lane >> 4;
    const int K = g.K, nt = K / BK;
    unsigned voffA[2], voffB[2];
#pragma unroll
    for (int i = 0; i < 2; ++i) { int R, C; stage_rc(tid * 16 + i * 8192, R, C); const int Rb = Epi::PERM ? ((R & ~31) + perm32(R & 31)) : R;
        voffA[i] = (unsigned)(R * K + C) * 2u; voffB[i] = (unsigned)(Rb * K + C) * 2u; }
    const size_t kstep = (size_t)(BK * 2);
    const size_t hstep = (size_t)HALF * K * 2;
    const size_t tstep = 2 * hstep;
    const unsigned ldsw = (unsigned)wid * 1024u;
    const int aoff = lds_byte(wr * 64 + fr, fq * 8), boff = lds_byte(wc * 32 + fr, fq * 8);
#define PG8_SA(b, h) (((b) * 2 + (h)) * HTB)
#define PG8_SB(b, h) ((4 + (b) * 2 + (h)) * HTB)
#define PG8_STAGE(bufoff, gbase, voff, AUX) do { _Pragma("unroll") for (int _i = 0; _i < 2; ++_i) \
        __builtin_amdgcn_global_load_lds((const unsigned*)((const char*)(gbase) + (voff)[_i]), (PG8_LAS unsigned*)(lds + (bufoff) + ldsw + _i * 8192), 16, 0, AUX); } while (0)
#define PG8_LDA(dst, b, h) do { _Pragma("unroll") for (int m = 0; m < 4; ++m) _Pragma("unroll") for (int k = 0; k < 2; ++k) dst[m][k] = *(const PG8_LAS bf16x8*)(lds + PG8_SA(b, h) + aoff + m * 2048 + k * 1024); } while (0)
#define PG8_LDB(dst, b, h) do { _Pragma("unroll") for (int n = 0; n < 2; ++n) _Pragma("unroll") for (int k = 0; k < 2; ++k) dst[n][k] = *(const PG8_LAS bf16x8*)(lds + PG8_SB(b, h) + boff + n * 2048 + k * 1024); } while (0)
#define PG8_MMA(ai, bj, At, Bt) do { __builtin_amdgcn_s_setprio(1); _Pragma("unroll") for (int m = 0; m < 4; ++m) _Pragma("unroll") for (int n = 0; n < 2; ++n) _Pragma("unroll") for (int k = 0; k < 2; ++k) \
        acc[ai][bj][m][n] = __builtin_amdgcn_mfma_f32_16x16x32_bf16(Bt[n][k], At[m][k], acc[ai][bj][m][n], 0, 0, 0); __builtin_amdgcn_s_setprio(0); } while (0)
#define PG8_WAIT_V(n) asm volatile("s_waitcnt vmcnt(" #n ")" ::: "memory")
#define PG8_WAIT_L(n) asm volatile("s_waitcnt lgkmcnt(" #n ")" ::: "memory")
#define PG8_BAR __builtin_amdgcn_s_barrier()
#define PG8_SCHED __builtin_amdgcn_sched_barrier(0)
    Unit cur, nxt; int ui = 0;
    if (!S.next(0, cur)) return;
    f32x4 acc[2][2][4][2];
#pragma unroll
    for (int a = 0; a < 2; ++a)
#pragma unroll
        for (int b = 0; b < 2; ++b)
#pragma unroll
            for (int m = 0; m < 4; ++m)
#pragma unroll
                for (int n = 0; n < 2; ++n) acc[a][b][m][n] = (f32x4){0.f, 0.f, 0.f, 0.f};
    bf16x8 At[4][2], B0[2][2], B1[2][2];
    const char* cA = (const char*)g.A + (size_t)cur.pm * tstep; const char* cB = (const char*)g.Bt + (size_t)cur.pn * tstep + (size_t)seq_of_pm(cur.pm) * g.bseq;
    S.a_ready(cur);
    PG8_STAGE(PG8_SB(0, 0), cB, voffB, Epi::B_AUX); PG8_STAGE(PG8_SA(0, 0), cA, voffA, Epi::A_AUX); PG8_STAGE(PG8_SB(0, 1), cB + hstep, voffB, Epi::B_AUX); PG8_STAGE(PG8_SA(0, 1), cA + hstep, voffA, Epi::A_AUX);
    if (wr == 1) PG8_BAR;
    PG8_WAIT_V(4); PG8_BAR;
    PG8_STAGE(PG8_SB(1, 0), cB + kstep, voffB, Epi::B_AUX); PG8_STAGE(PG8_SA(1, 0), cA + kstep, voffA, Epi::A_AUX); PG8_STAGE(PG8_SB(1, 1), cB + hstep + kstep, voffB, Epi::B_AUX);
    PG8_WAIT_V(6); PG8_BAR;
    for (;;) {
        const bool has_next = S.next(ui + 1, nxt);
        const char* nA = has_next ? (const char*)g.A + (size_t)nxt.pm * tstep : cA; const char* nB = has_next ? (const char*)g.Bt + (size_t)nxt.pn * tstep + (size_t)seq_of_pm(nxt.pm) * g.bseq : cB;
        for (int t = 0; t < nt; t += 2) {
            const bool last = (t == nt - 2);
            const char* a1 = cA + (size_t)(t + 1) * kstep;
            const char* a2 = last ? nA : cA + (size_t)(t + 2) * kstep; const char* b2 = last ? nB : cB + (size_t)(t + 2) * kstep;
            const char* a3 = a2 + kstep; const char* b3 = b2 + kstep;
            if (last && has_next) S.a_ready(nxt);
            PG8_LDB(B0, 0, 0); PG8_SCHED; PG8_LDA(At, 0, 0); PG8_STAGE(PG8_SA(1, 1), a1 + hstep, voffA, Epi::A_AUX);
            PG8_WAIT_L(8); PG8_BAR; PG8_WAIT_L(0); PG8_MMA(0, 0, At, B0); PG8_BAR; PG8_SCHED;
            PG8_LDB(B1, 0, 1); PG8_STAGE(PG8_SB(0, 0), b2, voffB, Epi::B_AUX);
            PG8_BAR; PG8_WAIT_L(0); PG8_MMA(0, 1, At, B1); PG8_BAR;
            PG8_LDA(At, 0, 1); PG8_STAGE(PG8_SA(0, 0), a2, voffA, Epi::A_AUX);
            PG8_BAR; PG8_WAIT_L(0); PG8_MMA(1, 0, At, B0); PG8_BAR; PG8_SCHED;
            PG8_STAGE(PG8_SB(0, 1), b2 + hstep, voffB, Epi::B_AUX);
            PG8_WAIT_V(6); PG8_BAR; PG8_MMA(1, 1, At, B1); PG8_BAR;
            PG8_LDB(B0, 1, 0); PG8_SCHED; PG8_LDA(At, 1, 0); PG8_STAGE(PG8_SA(0, 1), a2 + hstep, voffA, Epi::A_AUX);
            PG8_WAIT_L(8); PG8_BAR; PG8_WAIT_L(0); PG8_MMA(0, 0, At, B0); PG8_BAR; PG8_SCHED;
            PG8_LDB(B1, 1, 1); PG8_STAGE(PG8_SB(1, 0), b3, voffB, Epi::B_AUX);
            PG8_BAR; PG8_WAIT_L(0); PG8_MMA(0, 1, At, B1); PG8_BAR;
            PG8_LDA(At, 1, 1); PG8_STAGE(PG8_SA(1, 0), a3, voffA, Epi::A_AUX);
            PG8_BAR; PG8_WAIT_L(0); PG8_MMA(1, 0, At, B0); PG8_BAR; PG8_SCHED;
            PG8_STAGE(PG8_SB(1, 1), b3 + hstep, voffB, Epi::B_AUX);
            PG8_WAIT_V(6); PG8_BAR; PG8_MMA(1, 1, At, B1); PG8_BAR;
        }
        if constexpr (!Epi::AFTER_DRAIN) { E(acc, cur, wr, wc, fr, fq); S.done(cur); }
        if (!has_next) break;
#pragma unroll
        for (int a = 0; a < 2; ++a)
#pragma unroll
            for (int b = 0; b < 2; ++b)
#pragma unroll
                for (int m = 0; m < 4; ++m)
#pragma unroll
                    for (int n = 0; n < 2; ++n) acc[a][b][m][n] = (f32x4){0.f, 0.f, 0.f, 0.f};
        cur = nxt; cA = nA; cB = nB; ++ui;
    }
    PG8_WAIT_V(0);
    if (wr == 0) PG8_BAR;
    PG8_BAR;
    if constexpr (Epi::AFTER_DRAIN) { E.fused(acc, cur, wr, wc, fr, fq, lds, wid, lane); S.done(cur); }
#undef PG8_SA
#undef PG8_SB
#undef PG8_STAGE
#undef PG8_LDA
#undef PG8_LDB
#undef PG8_MMA
#undef PG8_WAIT_V
#undef PG8_WAIT_L
#undef PG8_BAR
#undef PG8_SCHED
}
}


using pg8::bf16_t; using pg8::bf16x8; using pg8::f32x4; using pg8::u32x4; using pg8::Unit;
typedef unsigned u32x2 __attribute__((ext_vector_type(2)));
#define LAS PG8_LAS
constexpr int T_TOK = 98304, T_P = 65536, DM = 1024, DFF = 2816;
constexpr int LDS_BYTES = 131072 + 16;
constexpr float EPSV = 1e-6f;

constexpr size_t WS_WAB_IN = 0;
constexpr size_t WS_WAB_OUT = WS_WAB_IN + (size_t)2560 * 1024 * 2;
constexpr size_t WS_WCD_IN = WS_WAB_OUT + (size_t)1024 * 1024 * 2;
constexpr size_t WS_WCD_OUT = WS_WCD_IN + (size_t)2048 * 1024 * 2;
constexpr size_t WS_WFFN_IN = WS_WCD_OUT + (size_t)1024 * 1024 * 2;
constexpr size_t WS_WFFN_OUT = WS_WFFN_IN + (size_t)2 * 5632 * 1024 * 2;
constexpr size_t WS_WS = WS_WFFN_OUT + (size_t)2 * 1024 * 2816 * 2;
constexpr size_t WS_MOD = WS_WS + (size_t)6 * 128 * 128 * 2;
constexpr size_t WS_DFT1 = WS_MOD + (size_t)2 * 10 * 6144 * 4;
constexpr size_t WS_DFT2A = WS_DFT1 + (size_t)256 * 256 * 2;
constexpr size_t WS_DFT2B = WS_DFT2A + (size_t)64 * 128 * 2;
constexpr size_t WS_H = WS_DFT2B + (size_t)128 * 256 * 2;
constexpr size_t WS_P = WS_H + (size_t)T_TOK * 1024 * 2;
constexpr size_t WS_Y1 = WS_P + (size_t)T_TOK * 2048 * 2;
constexpr size_t WS_RP = WS_P + (size_t)T_TOK * 2816 * 2;
constexpr size_t WS_BIAS = WS_RP + (size_t)4 * T_TOK * 16 * 4;
constexpr size_t WS_WF0 = WS_BIAS + (size_t)10 * (5632 + 2048 + 5632) * 4;
constexpr size_t WS_BAR = WS_WF0 + (size_t)10 * 5632 * 1024 * 2;
constexpr size_t WS_END = WS_BAR + 16384;
constexpr size_t DO_U = 0;
constexpr size_t DO_WCD = DO_U + (size_t)T_TOK * 1024 * 2;
constexpr size_t DO_WF1 = DO_WCD + (size_t)10 * 2048 * 1024 * 2;
constexpr size_t DO_END = DO_WF1 + (size_t)10 * 5632 * 1024 * 2;
static_assert(DO_END <= (size_t)T_TOK * 1024 * 4, "d_out scratch overflow");

#ifndef PROBE_SYNCS
#define PROBE_SYNCS 0
#endif
#ifndef PROBE_SG
#define PROBE_SG 0
#endif
#ifndef PROBE_HOT
#define PROBE_HOT 0
#endif
#ifndef PROBE_MASK
#define PROBE_MASK 0
#endif
struct Params { const float* in[24]; float* out; unsigned char* ws; int ph_lo, ph_hi; };

__device__ __forceinline__ int tid_opaque() { int t = threadIdx.x; asm volatile("" : "+v"(t)); return t; }
__device__ __forceinline__ int seq_of(int row) { return row < T_P ? (row >> 13) : 8 + ((row - T_P) >> 14); }
__device__ __forceinline__ float bf2f(unsigned short b) { return __uint_as_float(((unsigned)b) << 16); }
__device__ __forceinline__ unsigned pk2(float lo, float hi) { return pg8::cvt_pk_bf16(lo, hi); }
__device__ __forceinline__ float sigm(float x) { return __builtin_amdgcn_rcpf(1.0f + __builtin_amdgcn_exp2f(-1.44269504f * x)); }
__device__ __forceinline__ float wave_sum(float v) {
#pragma unroll
    for (int o = 32; o >= 1; o >>= 1) v += __shfl_xor(v, o);
    return v;
}

template <int KIND> struct EpiAct {
    static constexpr bool PERM = true, AFTER_DRAIN = false; static constexpr int A_AUX = 0, B_AUX = 0;
    bf16_t* O; int ldc; const float* rowpart; const float* bias; int nbias;
    __device__ __forceinline__ void operator()(const f32x4 (&acc)[2][2][4][2], const Unit& u, int wr, int wc, int fr, int fq) const {
        asm volatile("" : "+v"(fr), "+v"(fq));
        const int row0 = u.pm * 256 + wr * 64 + fr;
        float rs[2][4]; f32x4 bv[2][2];
        if (rowpart) {
#pragma unroll
            for (int ai = 0; ai < 2; ++ai)
#pragma unroll
                for (int m = 0; m < 4; ++m) { const f32x4 pv = *(const f32x4*)(rowpart + (size_t)(row0 + ai * 128 + m * 16) * 16 + 4 * fq);
                    float ss = (pv[0] + pv[1]) + (pv[2] + pv[3]); ss += __shfl_xor(ss, 16); ss += __shfl_xor(ss, 32);
                    rs[ai][m] = __builtin_amdgcn_rsqf(ss * (1.0f / 1024.0f) + EPSV); }
            const float* bp = bias + (size_t)seq_of(u.pm * 256) * nbias + u.pn * 256 + wc * 32 + 8 * fq;
#pragma unroll
            for (int bj = 0; bj < 2; ++bj)
#pragma unroll
                for (int n = 0; n < 2; ++n) bv[bj][n] = *(const f32x4*)(bp + bj * 128 + 4 * n);
        } else {
#pragma unroll
            for (int ai = 0; ai < 2; ++ai)
#pragma unroll
                for (int m = 0; m < 4; ++m) rs[ai][m] = 1.0f;
#pragma unroll
            for (int bj = 0; bj < 2; ++bj)
#pragma unroll
                for (int n = 0; n < 2; ++n) bv[bj][n] = (f32x4){0.f, 0.f, 0.f, 0.f};
        }
        int mode, colbase;
        if (KIND == 2) { mode = 0; colbase = u.pn * 256; }
        else if (KIND == 1) { mode = 3; colbase = u.pn * 128; }
        else { if (u.pn < 2) { mode = 0; colbase = u.pn * 256; } else if (u.pn < 6) { mode = 1; colbase = 512 + (u.pn - 2) * 128; } else { mode = 2; colbase = 1024 + (u.pn - 6) * 128; } }
        const int col0 = colbase + wc * 32 + 8 * fq;
#pragma unroll
        for (int ai = 0; ai < 2; ++ai)
#pragma unroll
            for (int m = 0; m < 4; ++m) { bf16_t* rowp = O + (size_t)(row0 + ai * 128 + m * 16) * ldc + col0;
                const float sc = rs[ai][m];
                const f32x4 a0 = acc[ai][0][m][0] * sc + bv[0][0], a1 = acc[ai][0][m][1] * sc + bv[0][1], b0 = acc[ai][1][m][0] * sc + bv[1][0], b1 = acc[ai][1][m][1] * sc + bv[1][1];
                if (mode == 0) {
                    u32x4 w; w.x = pk2(a0[0], a0[1]); w.y = pk2(a0[2], a0[3]); w.z = pk2(a1[0], a1[1]); w.w = pk2(a1[2], a1[3]);
                    __builtin_nontemporal_store(w, (u32x4*)rowp);
                    w.x = pk2(b0[0], b0[1]); w.y = pk2(b0[2], b0[3]); w.z = pk2(b1[0], b1[1]); w.w = pk2(b1[2], b1[3]);
                    __builtin_nontemporal_store(w, (u32x4*)(rowp + 128));
                } else {
                    float r[8];
#pragma unroll
                    for (int j = 0; j < 4; ++j) {
                        if (mode == 1) { r[j] = a0[j] * b0[j]; r[4 + j] = a1[j] * b1[j]; }
                        else if (mode == 2) { r[j] = a0[j] * sigm(b0[j]); r[4 + j] = a1[j] * sigm(b1[j]); }
                        else { r[j] = a0[j] * sigm(a0[j]) * b0[j]; r[4 + j] = a1[j] * sigm(a1[j]) * b1[j]; } }
                    u32x4 w; w.x = pk2(r[0], r[1]); w.y = pk2(r[2], r[3]); w.z = pk2(r[4], r[5]); w.w = pk2(r[6], r[7]);
                    __builtin_nontemporal_store(w, (u32x4*)rowp); }
            }
    }
};
#ifndef RES_A_AUX
#define RES_A_AUX 0
#endif
template <bool SRC_F32> struct EpiRes {
    static constexpr bool PERM = true, AFTER_DRAIN = false; static constexpr int A_AUX = RES_A_AUX, B_AUX = 0;
    const float* src0; const float* src1; bf16_t* X; const float* gate; float* rowpart;
    __device__ __forceinline__ void operator()(const f32x4 (&acc)[2][2][4][2], const Unit& u, int wr, int wc, int fr, int fq) const {
        asm volatile("" : "+v"(fr), "+v"(fq));
        const int rowl = wr * 64 + fr, col0 = u.pn * 256 + wc * 32 + 8 * fq, rbase = u.pm * 256;
        const int seq = seq_of(rbase);
        const float* gp = gate + (size_t)seq * 6144 + col0;
        f32x4 gv[2][2];
#pragma unroll
        for (int bj = 0; bj < 2; ++bj)
#pragma unroll
            for (int n = 0; n < 2; ++n) gv[bj][n] = *(const f32x4*)(gp + bj * 128 + 4 * n);
        bf16_t* xb = X + (size_t)rbase * 1024 + col0;
        const float* sb = (rbase < T_P) ? src0 + (size_t)rbase * 1024 + col0 : src1 + (size_t)(rbase - T_P) * 1024 + col0;
#pragma unroll
        for (int ai = 0; ai < 2; ++ai) {
            f32x4 sv[4][2][2];
            if (SRC_F32) {
#pragma unroll
                for (int m = 0; m < 4; ++m)
#pragma unroll
                    for (int bj = 0; bj < 2; ++bj)
#pragma unroll
                        for (int n = 0; n < 2; ++n) sv[m][bj][n] = *(const f32x4*)(sb + (size_t)(rowl + ai * 128 + m * 16) * 1024 + bj * 128 + 4 * n);
            } else {
                u32x4 raw[4][2];
#pragma unroll
                for (int m = 0; m < 4; ++m)
#pragma unroll
                    for (int bj = 0; bj < 2; ++bj) raw[m][bj] = *(const u32x4*)(xb + (size_t)(rowl + ai * 128 + m * 16) * 1024 + bj * 128);
#pragma unroll
                for (int m = 0; m < 4; ++m)
#pragma unroll
                    for (int bj = 0; bj < 2; ++bj) { const u32x4 r = raw[m][bj];
                        sv[m][bj][0] = (f32x4){__uint_as_float(r.x << 16), __uint_as_float(r.x & 0xffff0000u), __uint_as_float(r.y << 16), __uint_as_float(r.y & 0xffff0000u)};
                        sv[m][bj][1] = (f32x4){__uint_as_float(r.z << 16), __uint_as_float(r.z & 0xffff0000u), __uint_as_float(r.w << 16), __uint_as_float(r.w & 0xffff0000u)}; }
            }
#pragma unroll
            for (int m = 0; m < 4; ++m) { const int rl = rowl + ai * 128 + m * 16; float ss = 0.f;
#pragma unroll
                for (int bj = 0; bj < 2; ++bj) { const f32x4 x0 = sv[m][bj][0] + gv[bj][0] * acc[ai][bj][m][0], x1 = sv[m][bj][1] + gv[bj][1] * acc[ai][bj][m][1];
                    ss += (x0[0] * x0[0] + x0[1] * x0[1]) + (x0[2] * x0[2] + x0[3] * x0[3]) + (x1[0] * x1[0] + x1[1] * x1[1]) + (x1[2] * x1[2] + x1[3] * x1[3]);
                    u32x4 w; w.x = pk2(x0[0], x0[1]); w.y = pk2(x0[2], x0[3]); w.z = pk2(x1[0], x1[1]); w.w = pk2(x1[2], x1[3]);
                    *(u32x4*)(xb + (size_t)rl * 1024 + bj * 128) = w; }
                ss += __shfl_xor(ss, 16); ss += __shfl_xor(ss, 32);
                if (fq == 0) rowpart[(size_t)(rbase + rl) * 16 + u.pn * 4 + wc] = ss; }
            asm volatile("" ::: "memory");
        }
    }
};

__device__ __forceinline__ int map_ab(int n0) {
    if (n0 < 512) return n0;
    if (n0 < 1536) { const int q = (n0 - 512) >> 8, r = (n0 - 512) & 255; return r < 128 ? 512 + 128 * q + r : 1024 + 128 * q + (r - 128); }
    const int q = (n0 - 1536) >> 8, r = (n0 - 1536) & 255; return r < 128 ? 1536 + 128 * q + r : 2048 + 128 * q + (r - 128);
}
__device__ __forceinline__ int map_ffn(int n0) { const int q = n0 >> 8, r = n0 & 255; return r < 128 ? 128 * q + r : 2816 + 128 * q + (r - 128); }

__device__ __forceinline__ void tile_load(const float* __restrict__ src, int ld, int c0, int k0, float* tile) {
    const int tid = tid_opaque();
#pragma unroll
    for (int p = 0; p < 2; ++p) { const int r = (tid >> 4) + p * 32, c4 = (tid & 15) * 4;
        const f32x4 v = *(const f32x4*)(src + (size_t)(k0 + r) * ld + c0 + c4);
        float* t = tile + r * 65 + c4; t[0] = v[0]; t[1] = v[1]; t[2] = v[2]; t[3] = v[3]; }
}
__device__ __forceinline__ void tile_store_t(const float* tile, bf16_t* __restrict__ dst, int ldd, int n0, int k0) {
    const int tid = tid_opaque(), n = tid >> 3, k8 = (tid & 7) * 8;
    float f[8];
#pragma unroll
    for (int i = 0; i < 8; ++i) f[i] = tile[(k8 + i) * 65 + n];
    u32x4 w; w.x = pk2(f[0], f[1]); w.y = pk2(f[2], f[3]); w.z = pk2(f[4], f[5]); w.w = pk2(f[6], f[7]);
    *(u32x4*)(dst + (size_t)(n0 + n) * ldd + k0 + k8) = w;
}

__device__ void phase_prep(const Params& p, unsigned char* smem) {
    const int tid = tid_opaque(), lane = tid & 63, wave = tid >> 6, G = gridDim.x, bid = blockIdx.x;
    unsigned char* ws = p.ws;
    {
        float* sc = (float*)smem;
        float* red = sc + 10240;
        bool have = false;
        for (int task = bid; task < 192; task += G) {
            if (!have) { for (int i = tid; i < 10240; i += 512) { const float c = i < 8192 ? p.in[2][i] : p.in[3][i - 8192]; sc[i] = c * sigm(c); } have = true; }
            __syncthreads();
            const int l = task / 96, cb = task % 96, j = cb * 64 + lane;
            const float* W = p.in[4] + (size_t)l * 1024 * 6144 + j;
            float acc[10];
#pragma unroll
            for (int s = 0; s < 10; ++s) acc[s] = 0.f;
            const int kbeg = wave * 128;
#pragma unroll 8
            for (int k = 0; k < 128; ++k) { const float w = W[(size_t)(kbeg + k) * 6144];
#pragma unroll
                for (int s = 0; s < 10; ++s) acc[s] = fmaf(sc[s * 1024 + kbeg + k], w, acc[s]); }
#pragma unroll
            for (int s = 0; s < 10; ++s) red[(wave * 10 + s) * 64 + lane] = acc[s];
            __syncthreads();
            for (int i = tid; i < 640; i += 512) { const int s = i >> 6, ln = i & 63; float v = 0.f;
#pragma unroll
                for (int w = 0; w < 8; ++w) v += red[(w * 10 + s) * 64 + ln];
                const int jj = cb * 64 + ln; v += p.in[5][l * 6144 + jj];
                const int chunk = jj >> 10, d = jj & 1023;
                if (chunk == 1) v = p.in[6][l * 1024 + d] * (1.0f + v); else if (chunk == 4) v = p.in[7][l * 1024 + d] * (1.0f + v);
                ((float*)(ws + WS_MOD))[(size_t)(l * 10 + s) * 6144 + jj] = v; }
            __syncthreads();
        }
        __syncthreads();
    }
    {
        const int gt = bid * 512 + tid, gn = G * 512;
        bf16_t* wsb = (bf16_t*)(ws + WS_WS);
        for (int i = gt; i < 6 * 128 * 128 / 2; i += gn) ((unsigned*)wsb)[i] = pk2(p.in[18][2 * i], p.in[18][2 * i + 1]);
        bf16_t* d1 = (bf16_t*)(ws + WS_DFT1);
        for (int i = gt; i < 256 * 256 / 2; i += gn) { float v[2];
#pragma unroll
            for (int e = 0; e < 2; ++e) { const int idx = 2 * i + e, m = idx >> 8, k = idx & 255, po = m >> 7, ka = m & 127, pi = k >> 7, a = k & 127;
                const float rev = (float)((ka * a) & 127) * (1.0f / 128.0f); const float c = __builtin_amdgcn_cosf(rev), s = __builtin_amdgcn_sinf(rev);
                v[e] = po == 0 ? (pi == 0 ? c : -s) : (pi == 0 ? -s : -c); }
            ((unsigned*)d1)[i] = pk2(v[0], v[1]); }
        bf16_t* d2a = (bf16_t*)(ws + WS_DFT2A);
        for (int i = gt; i < 64 * 128 / 2; i += gn) { float v[2];
#pragma unroll
            for (int e = 0; e < 2; ++e) { const int idx = 2 * i + e, kb = idx >> 7, k = idx & 127, pi = k >> 6, b = k & 63;
                const float rev = (float)((kb * b) & 63) * (1.0f / 64.0f); v[e] = pi == 0 ? __builtin_amdgcn_cosf(rev) : __builtin_amdgcn_sinf(rev); }
            ((unsigned*)d2a)[i] = pk2(v[0], v[1]); }
        bf16_t* d2b = (bf16_t*)(ws + WS_DFT2B);
        for (int i = gt; i < 128 * 256 / 2; i += gn) { float v[2];
#pragma unroll
            for (int e = 0; e < 2; ++e) { const int idx = 2 * i + e, kb = idx >> 8, k = idx & 255, pi = k >> 7, b = k & 127;
                const float rev = (float)((kb * b) & 127) * (1.0f / 128.0f); v[e] = pi == 0 ? __builtin_amdgcn_cosf(rev) : __builtin_amdgcn_sinf(rev); }
            ((unsigned*)d2b)[i] = pk2(v[0], v[1]); }
    }
    {
        float* tile = (float*)smem;
        float* trig = tile + 64 * 65;
        if (tid < 64) { const float rev = (float)tid * (1.0f / 64.0f); trig[tid] = __builtin_amdgcn_cosf(rev); trig[64 + tid] = __builtin_amdgcn_sinf(rev); }
        __syncthreads();
        for (int id = bid; id < 5824; id += G) {
            const float* src; int ld, c0, k0, n0, ldd; bf16_t* dst; bool fold = false; int fg = 0;
            if (id < 640) { const int kt = id & 15, nt = id >> 4; src = p.in[8]; ld = 2560; k0 = kt * 64; n0 = nt * 64; c0 = map_ab(n0); dst = (bf16_t*)(ws + WS_WAB_IN); ldd = 1024; }
            else if (id < 896) { const int i2 = id - 640, kt = i2 & 15, nt = i2 >> 4; src = p.in[14]; ld = 1024; k0 = kt * 64; n0 = nt * 64; c0 = n0; dst = (bf16_t*)(ws + WS_WAB_OUT); ldd = 1024; }
            else if (id < 1280) { const int i2 = id - 896, kt = i2 & 15, nt = i2 >> 4; src = p.in[15]; ld = 1792; k0 = kt * 64; n0 = nt * 64; c0 = n0; dst = (bf16_t*)(ws + WS_WCD_IN); ldd = 1024; }
            else if (id < 1344) { const int i2 = id - 1280, kt = i2 & 15; fg = i2 >> 4; src = p.in[15]; ld = 1792; k0 = kt * 64; n0 = 0; c0 = 1536 + 64 * fg; dst = (bf16_t*)(ws + WS_WCD_IN); ldd = 1024; fold = true; }
            else if (id < 1600) { const int i2 = id - 1344, kt = i2 & 15, nt = i2 >> 4; src = p.in[20]; ld = 1024; k0 = kt * 64; n0 = nt * 64; c0 = n0; dst = (bf16_t*)(ws + WS_WCD_OUT); ldd = 1024; }
            else if (id < 4416) { const int i2 = id - 1600, l = i2 / 1408, i3 = i2 % 1408, kt = i3 & 15, nt = i3 >> 4; src = p.in[21] + (size_t)l * 1024 * 5632; ld = 5632; k0 = kt * 64; n0 = nt * 64; c0 = map_ffn(n0);
                dst = (bf16_t*)(ws + WS_WFFN_IN) + (size_t)l * 5632 * 1024; ldd = 1024; }
            else { const int i2 = id - 4416, l = i2 / 704, i3 = i2 % 704, kt = i3 % 44, nt = i3 / 44; src = p.in[22] + (size_t)l * 2816 * 1024; ld = 1024; k0 = kt * 64; n0 = nt * 64; c0 = n0;
                dst = (bf16_t*)(ws + WS_WFFN_OUT) + (size_t)l * 1024 * 2816; ldd = 2816; }
            tile_load(src, ld, c0, k0, tile);
            __syncthreads();
            if (!fold) tile_store_t(tile, dst, ldd, n0, k0);
            else {
                const int np = tid >> 2, part = np >> 6, k2 = np & 63, kq = tid & 3;
                const float* tr = trig + part * 64;
                float a[16];
#pragma unroll
                for (int i = 0; i < 16; ++i) a[i] = 0.f;
                for (int n2 = 0; n2 < 64; ++n2) { const float t = tr[(k2 * n2) & 63];
#pragma unroll
                    for (int i = 0; i < 16; ++i) a[i] = fmaf(tile[(kq * 16 + i) * 65 + n2], t, a[i]); }
                bf16_t* dp = dst + (size_t)(1536 + part * 256 + fg * 64 + k2) * 1024 + k0 + kq * 16;
                u32x4 w0, w1;
                w0.x = pk2(a[0], a[1]); w0.y = pk2(a[2], a[3]); w0.z = pk2(a[4], a[5]); w0.w = pk2(a[6], a[7]);
                w1.x = pk2(a[8], a[9]); w1.y = pk2(a[10], a[11]); w1.z = pk2(a[12], a[13]); w1.w = pk2(a[14], a[15]);
                *(u32x4*)dp = w0; *(u32x4*)(dp + 8) = w1;
            }
            __syncthreads();
        }
    }
}

__device__ void phase_norm(const float* src0, const float* src1, const float* modl, int chA, int chB, bf16_t* H) {
    const int tid = tid_opaque(), lane = tid & 63, wave = tid >> 6;
    const int nw = gridDim.x * 8;
    for (int row = blockIdx.x * 8 + wave; row < T_TOK; row += 2 * nw) {
        f32x4 v[2][4]; float ss[2];
#pragma unroll
        for (int r = 0; r < 2; ++r) { const int rr = (row + r * nw < T_TOK) ? row + r * nw : row;
            const float* xp = rr < T_P ? src0 + (size_t)rr * 1024 : src1 + (size_t)(rr - T_P) * 1024;
#pragma unroll
            for (int i = 0; i < 4; ++i) v[r][i] = *(const f32x4*)(xp + i * 256 + lane * 4); }
#pragma unroll
        for (int r = 0; r < 2; ++r) { float s = 0.f;
#pragma unroll
            for (int i = 0; i < 4; ++i) s += v[r][i][0] * v[r][i][0] + v[r][i][1] * v[r][i][1] + v[r][i][2] * v[r][i][2] + v[r][i][3] * v[r][i][3];
            ss[r] = wave_sum(s); }
#pragma unroll
        for (int r = 0; r < 2; ++r) { const int rr = row + r * nw; if (rr >= T_TOK) break;
            const float rstd = __builtin_amdgcn_rsqf(ss[r] * (1.0f / 1024.0f) + EPSV);
            const float* mp = modl + (size_t)seq_of(rr) * 6144;
#pragma unroll
            for (int i = 0; i < 4; ++i) { const f32x4 A = *(const f32x4*)(mp + chA * 1024 + i * 256 + lane * 4), B = *(const f32x4*)(mp + chB * 1024 + i * 256 + lane * 4);
                const f32x4 h = v[r][i] * rstd * A + B; u32x2 w; w.x = pk2(h[0], h[1]); w.y = pk2(h[2], h[3]);
                *(u32x2*)(H + (size_t)rr * 1024 + i * 256 + lane * 4) = w; } }
    }
}
__device__ void phase_final(float* out, const bf16_t* X, const float* rowpart, const float* g) {
    const int tid = tid_opaque(), lane = tid & 63, wave = tid >> 6;
    const int nw = gridDim.x * 8;
    f32x4 gv[4];
#pragma unroll
    for (int i = 0; i < 2; ++i) { gv[2 * i] = *(const f32x4*)(g + i * 512 + lane * 8); gv[2 * i + 1] = *(const f32x4*)(g + i * 512 + lane * 8 + 4); }
    for (int row = blockIdx.x * 8 + wave; row < T_TOK; row += 2 * nw) {
        u32x4 v[2][2]; f32x4 pp[2][4];
#pragma unroll
        for (int r = 0; r < 2; ++r) { const int rr = (row + r * nw < T_TOK) ? row + r * nw : row;
#pragma unroll
            for (int i = 0; i < 2; ++i) v[r][i] = *(const u32x4*)(X + (size_t)rr * 1024 + i * 512 + lane * 8);
#pragma unroll
            for (int i = 0; i < 4; ++i) pp[r][i] = *(const f32x4*)(rowpart + (size_t)rr * 16 + i * 4); }
#pragma unroll
        for (int r = 0; r < 2; ++r) { const int rr = row + r * nw; if (rr >= T_TOK) break;
            float ss = 0.f;
#pragma unroll
            for (int i = 0; i < 4; ++i) ss += (pp[r][i][0] + pp[r][i][1]) + (pp[r][i][2] + pp[r][i][3]);
            const float rstd = __builtin_amdgcn_rsqf(ss * (1.0f / 1024.0f) + EPSV);
            float* xp = out + (size_t)rr * 1024;
#pragma unroll
            for (int i = 0; i < 2; ++i) { const u32x4 q = v[r][i];
                const f32x4 a = (f32x4){__uint_as_float(q.x << 16), __uint_as_float(q.x & 0xffff0000u), __uint_as_float(q.y << 16), __uint_as_float(q.y & 0xffff0000u)};
                const f32x4 b = (f32x4){__uint_as_float(q.z << 16), __uint_as_float(q.z & 0xffff0000u), __uint_as_float(q.w << 16), __uint_as_float(q.w & 0xffff0000u)};
                *(f32x4*)(xp + i * 512 + lane * 8) = a * rstd * gv[2 * i]; *(f32x4*)(xp + i * 512 + lane * 8 + 4) = b * rstd * gv[2 * i + 1]; } }
    }
}
__device__ __forceinline__ void tile_store_scaled(const float* tile, bf16_t* __restrict__ dst, size_t seqstride, const float* __restrict__ avec, int n0, int k0) {
    const int tid = threadIdx.x, n = tid >> 3, k8 = (tid & 7) * 8;
    float f[8];
#pragma unroll
    for (int i = 0; i < 8; ++i) f[i] = tile[(k8 + i) * 65 + n];
#pragma unroll 2
    for (int sq = 0; sq < 10; ++sq) { const f32x4 a0 = *(const f32x4*)(avec + (size_t)sq * 6144 + k0 + k8), a1 = *(const f32x4*)(avec + (size_t)sq * 6144 + k0 + k8 + 4);
        u32x4 w; w.x = pk2(f[0] * a0[0], f[1] * a0[1]); w.y = pk2(f[2] * a0[2], f[3] * a0[3]); w.z = pk2(f[4] * a1[0], f[5] * a1[1]); w.w = pk2(f[6] * a1[2], f[7] * a1[3]);
        *(u32x4*)(dst + (size_t)sq * seqstride + (size_t)(n0 + n) * 1024 + k0 + k8) = w; }
}
__device__ void phase_wscaled(const Params& p, unsigned char* smem) {
    const int tid = tid_opaque();
    const float* mod = (const float*)(p.ws + WS_MOD);
    float* av = (float*)smem;
#pragma unroll 1
    for (int c = 0; c < 3; ++c) {
        const int N = (c == 1) ? 2048 : 5632;
        const float* avec = c == 0 ? mod + 4 * 1024 : c == 1 ? mod + 61440 + 1 * 1024 : mod + 61440 + 4 * 1024;
        const bf16_t* Bt = c == 0 ? (const bf16_t*)(p.ws + WS_WFFN_IN) : c == 1 ? (const bf16_t*)(p.ws + WS_WCD_IN) : (const bf16_t*)(p.ws + WS_WFFN_IN) + (size_t)5632 * 1024;
        bf16_t* dst = c == 0 ? (bf16_t*)(p.ws + WS_WF0) : c == 1 ? (bf16_t*)((unsigned char*)p.out + DO_WCD) : (bf16_t*)((unsigned char*)p.out + DO_WF1);
        const size_t sstr = (size_t)N * 1024;
        __syncthreads();
        for (int i = tid; i < 10240; i += 512) av[i] = avec[(size_t)(i >> 10) * 6144 + (i & 1023)];
        __syncthreads();
        const int nchunk = N * 128;
        for (int ch = blockIdx.x * 512 + tid; ch < nchunk; ch += gridDim.x * 512) {
            const int k8 = (ch & 127) * 8;
            const u32x4 wv = *(const u32x4*)(Bt + (size_t)ch * 8);
            float f[8];
#pragma unroll
            for (int e = 0; e < 4; ++e) { f[2 * e] = __uint_as_float(wv[e] << 16); f[2 * e + 1] = __uint_as_float(wv[e] & 0xffff0000u); }
#pragma unroll
            for (int sq = 0; sq < 10; ++sq) { const f32x4 a0 = *(const f32x4*)(av + sq * 1024 + k8), a1 = *(const f32x4*)(av + sq * 1024 + k8 + 4);
                u32x4 w; w.x = pk2(f[0] * a0[0], f[1] * a0[1]); w.y = pk2(f[2] * a0[2], f[3] * a0[3]); w.z = pk2(f[4] * a1[0], f[5] * a1[1]); w.w = pk2(f[6] * a1[2], f[7] * a1[3]);
                *(u32x4*)(dst + (size_t)sq * sstr + (size_t)ch * 8) = w; }
        }
    }
    __syncthreads();
}
__device__ void phase_bias(const Params& p, unsigned char* smem) {
    const int tid = tid_opaque(), lane = tid & 63, wave = tid >> 6, nw = gridDim.x * 8;
    float* sh = (float*)smem;
    const float* mod = (const float*)(p.ws + WS_MOD);
    float* biasb = (float*)(p.ws + WS_BIAS);
#pragma unroll 1
    for (int c = 0; c < 3; ++c) {
        const int N = (c == 1) ? 2048 : 5632;
        const float* shp = mod + (size_t)(c == 0 ? 0 : 1) * 61440 + (c == 1 ? 0 : 3) * 1024;
        const bf16_t* Bt = c == 0 ? (const bf16_t*)(p.ws + WS_WFFN_IN) : c == 1 ? (const bf16_t*)(p.ws + WS_WCD_IN) : (const bf16_t*)(p.ws + WS_WFFN_IN) + (size_t)5632 * 1024;
        float* bo = biasb + (c == 0 ? 0 : c == 1 ? 56320 : 56320 + 20480);
        __syncthreads();
        for (int i = tid; i < 10240; i += 512) sh[i] = shp[(size_t)(i >> 10) * 6144 + (i & 1023)];
        __syncthreads();
        for (int n = blockIdx.x * 8 + wave; n < N; n += nw) {
            const u32x4 w0 = *(const u32x4*)(Bt + (size_t)n * 1024 + lane * 16), w1 = *(const u32x4*)(Bt + (size_t)n * 1024 + lane * 16 + 8);
            float wf[16];
#pragma unroll
            for (int e = 0; e < 4; ++e) { wf[2 * e] = __uint_as_float(w0[e] << 16); wf[2 * e + 1] = __uint_as_float(w0[e] & 0xffff0000u); wf[8 + 2 * e] = __uint_as_float(w1[e] << 16); wf[8 + 2 * e + 1] = __uint_as_float(w1[e] & 0xffff0000u); }
            float my = 0.f;
#pragma unroll
            for (int sq = 0; sq < 10; ++sq) { float d = 0.f;
#pragma unroll
                for (int q = 0; q < 4; ++q) { const f32x4 b = *(const f32x4*)(sh + sq * 1024 + lane * 16 + q * 4); d += wf[q * 4] * b[0] + wf[q * 4 + 1] * b[1] + wf[q * 4 + 2] * b[2] + wf[q * 4 + 3] * b[3]; }
                d = wave_sum(d); if (lane == sq) my = d; }
            if (lane < 10) bo[(size_t)lane * N + n] = my;
        }
    }
    __syncthreads();
}

__device__ void phase_conv(const Params& p, unsigned char* smem) {
    const int tid = tid_opaque(), lane = tid & 63, wave = tid >> 6;
    const bf16_t* P0 = (const bf16_t*)(p.ws + WS_P);
    bf16_t* U = (bf16_t*)((unsigned char*)p.out + DO_U);
    bf16_t* gt = (bf16_t*)smem;
    float* zt = (float*)(smem + 94 * 1024);
    const float* wa = p.in[9];
    const float* wb = p.in[10];
    float w[31];
#pragma unroll
    for (int k = 0; k < 31; ++k) w[k] = wb[k * 512 + tid];
    const float bias = p.in[11][tid];
    float lg[8], lb[8];
#pragma unroll
    for (int i = 0; i < 8; ++i) { lg[i] = p.in[12][lane * 8 + i]; lb[i] = p.in[13][lane * 8 + i]; }
    const int ntiles = T_TOK / 64;
#define CONV_STAGE_LOAD(tile_, SG) do { const int t0_ = (tile_) * 64, seq_ = seq_of(t0_); \
        const int s0_ = seq_ < 8 ? seq_ * 8192 : T_P + (seq_ - 8) * 16384, s1_ = s0_ + (seq_ < 8 ? 8192 : 16384); \
        _Pragma("unroll") for (int j = 0; j < 12; ++j) { const int i = tid + 512 * j, r = i >> 6, ch = i & 63, tok = t0_ - 15 + r; \
            SG[j] = (u32x4){0u, 0u, 0u, 0u}; \
            if (i < 94 * 64 && tok >= s0_ && tok < s1_) SG[j] = *(const u32x4*)(P0 + (size_t)tok * 1536 + 1024 + ch * 8); } } while (0)
    u32x4 sg[12];
    if ((int)blockIdx.x < ntiles) CONV_STAGE_LOAD((int)blockIdx.x, sg);
    for (int tile = blockIdx.x; tile < ntiles; tile += gridDim.x) {
        const int t0 = tile * 64, seq = seq_of(t0);
        const int s0 = seq < 8 ? seq * 8192 : T_P + (seq - 8) * 16384, s1 = s0 + (seq < 8 ? 8192 : 16384);
#pragma unroll
        for (int j = 0; j < 12; ++j) { const int i = tid + 512 * j, r = i >> 6, ch = i & 63; if (i < 94 * 64) *(u32x4*)(gt + r * 512 + ch * 8) = sg[j]; }
        __syncthreads();
        if (tile + (int)gridDim.x < ntiles) CONV_STAGE_LOAD(tile + (int)gridDim.x, sg);
#pragma unroll 1
        for (int grp = 0; grp < 4; ++grp) {
            u32x4 yab[2], yx0[2], yxm[2], yxp[2];
#pragma unroll
            for (int j = 0; j < 2; ++j) { const int i = tid + 512 * j, t = grp * 16 + (i >> 6), ch = i & 63, tok = t0 + t, c0 = ch * 8;
                const bf16_t* rp = P0 + (size_t)tok * 1536;
                yab[j] = *(const u32x4*)(rp + c0); yx0[j] = *(const u32x4*)(rp + 512 + c0);
                yxm[j] = (u32x4){0u, 0u, 0u, 0u}; yxp[j] = (u32x4){0u, 0u, 0u, 0u};
                if (tok - 1 >= s0) yxm[j] = *(const u32x4*)(rp - 1536 + 512 + c0);
                if (tok + 1 < s1) yxp[j] = *(const u32x4*)(rp + 1536 + 512 + c0); }
            float g[46];
#pragma unroll
            for (int i = 0; i < 46; ++i) g[i] = bf2f(gt[(grp * 16 + i) * 512 + tid]);
#pragma unroll
            for (int t = 0; t < 16; ++t) { float a = bias;
#pragma unroll
                for (int k = 0; k < 31; ++k) a = fmaf(w[k], g[t + k], a);
                zt[t * 512 + tid] = a; }
            __syncthreads();
#pragma unroll
            for (int tt = 0; tt < 2; ++tt) { const int t = wave * 2 + tt;
                const f32x4 z0 = *(const f32x4*)(zt + t * 512 + lane * 8), z1 = *(const f32x4*)(zt + t * 512 + lane * 8 + 4);
                float s = (z0[0] + z0[1]) + (z0[2] + z0[3]) + (z1[0] + z1[1]) + (z1[2] + z1[3]);
                s = wave_sum(s); const float mu = s * (1.0f / 512.0f);
                const f32x4 d0 = z0 - mu, d1 = z1 - mu;
                float q = d0[0] * d0[0] + d0[1] * d0[1] + d0[2] * d0[2] + d0[3] * d0[3] + d1[0] * d1[0] + d1[1] * d1[1] + d1[2] * d1[2] + d1[3] * d1[3];
                q = wave_sum(q); const float rstd = __builtin_amdgcn_rsqf(q * (1.0f / 512.0f) + EPSV);
                float r[8];
#pragma unroll
                for (int e = 0; e < 8; ++e) { const float d = e < 4 ? d0[e & 3] : d1[e & 3]; const float y = d * rstd * lg[e] + lb[e]; r[e] = y * sigm(y); }
                u32x4 o; o.x = pk2(r[0], r[1]); o.y = pk2(r[2], r[3]); o.z = pk2(r[4], r[5]); o.w = pk2(r[6], r[7]);
                *(u32x4*)(U + (size_t)(t0 + grp * 16 + t) * 1024 + 512 + lane * 8) = o; }
#pragma unroll
            for (int j = 0; j < 2; ++j) { const int i = tid + 512 * j, t = grp * 16 + (i >> 6), ch = i & 63, tok = t0 + t, c0 = ch * 8;
                const u32x4 ab = yab[j], x0 = yx0[j], xm = yxm[j], xp = yxp[j];
                const f32x4 w0a = *(const f32x4*)(wa + c0), w0b = *(const f32x4*)(wa + c0 + 4), w1a = *(const f32x4*)(wa + 512 + c0), w1b = *(const f32x4*)(wa + 512 + c0 + 4),
                            w2a = *(const f32x4*)(wa + 1024 + c0), w2b = *(const f32x4*)(wa + 1024 + c0 + 4);
                float r[8];
#pragma unroll
                for (int e = 0; e < 8; ++e) { const unsigned sh = (e & 1) * 16; const int q = e >> 1;
                    const float fab = __uint_as_float((ab[q] >> sh) << 16), f0 = __uint_as_float((x0[q] >> sh) << 16), fm = __uint_as_float((xm[q] >> sh) << 16), fp = __uint_as_float((xp[q] >> sh) << 16);
                    const float k0 = e < 4 ? w0a[e & 3] : w0b[e & 3], k1 = e < 4 ? w1a[e & 3] : w1b[e & 3], k2 = e < 4 ? w2a[e & 3] : w2b[e & 3];
                    r[e] = fab * (k0 * fm + k1 * f0 + k2 * fp); }
                u32x4 o; o.x = pk2(r[0], r[1]); o.y = pk2(r[2], r[3]); o.z = pk2(r[4], r[5]); o.w = pk2(r[6], r[7]);
                *(u32x4*)(U + (size_t)tok * 1024 + c0) = o; }
            __syncthreads();
        }
    }
#undef CONV_STAGE_LOAD
}

__device__ void phase_sg(const Params& p, unsigned char* smem) {
    const int tid = tid_opaque(), lane = tid & 63, wave = tid >> 6, fr = lane & 15, fq = lane >> 4;
    const bf16_t* P1 = (const bf16_t*)(p.ws + WS_P);
    bf16_t* U = (bf16_t*)((unsigned char*)p.out + DO_U);
    const bf16_t* Wsb = (const bf16_t*)(p.ws + WS_WS);
    float* st = (float*)smem;
    bf16_t* vnT = (bf16_t*)(smem + 1024);
    constexpr int PITCH = 136;
    const int pp = wave * 16 + fr;
#define SG_LOAD(h_, WF, UU, BS, VA) do { \
        _Pragma("unroll") for (int kk = 0; kk < 4; ++kk) WF[kk] = *(const bf16x8*)(Wsb + (size_t)((h_) * 128 + pp) * 128 + kk * 32 + fq * 8); \
        _Pragma("unroll") for (int mt = 0; mt < 8; ++mt) UU[mt] = *(const u32x2*)(P1 + (size_t)(t0 + pp) * 2048 + (h_) * 128 + mt * 16 + 4 * fq); \
        BS = p.in[19][(h_) * 128 + pp]; \
        _Pragma("unroll") for (int j = 0; j < 4; ++j) { const int item = tid + 512 * j, q = item & 127, dc = item >> 7; VA[j] = *(const u32x4*)(P1 + (size_t)(t0 + q) * 2048 + 768 + (h_) * 128 + dc * 8); } \
    } while (0)
    for (int chunk = blockIdx.x; chunk < T_TOK / 128; chunk += gridDim.x) {
        const int t0 = chunk * 128;
        bf16x8 wfN[4]; u32x2 uuN[8]; float bsN; u32x4 vaN[4];
        SG_LOAD(0, wfN, uuN, bsN, vaN);
#pragma unroll 1
        for (int half = 0; half < 2; ++half) {
            u32x4 av[8], bv[8];
#pragma unroll
            for (int tt = 0; tt < 8; ++tt) { const int q = wave * 16 + half * 8 + tt; const bf16_t* vp = P1 + (size_t)(t0 + q) * 2048 + 768;
                av[tt] = *(const u32x4*)(vp + lane * 8); bv[tt] = (u32x4){0u, 0u, 0u, 0u}; if (lane < 32) bv[tt] = *(const u32x4*)(vp + 512 + lane * 8); }
#pragma unroll
            for (int tt = 0; tt < 8; ++tt) { const int q = wave * 16 + half * 8 + tt; const u32x4 a = av[tt], b = bv[tt];
                float s = 0.f, ss = 0.f;
#pragma unroll
                for (int e = 0; e < 4; ++e) { const float x0 = __uint_as_float(a[e] << 16), x1 = __uint_as_float(a[e] & 0xffff0000u), y0 = __uint_as_float(b[e] << 16), y1 = __uint_as_float(b[e] & 0xffff0000u);
                    s += (x0 + x1) + (y0 + y1); ss += (x0 * x0 + x1 * x1) + (y0 * y0 + y1 * y1); }
                s = wave_sum(s); ss = wave_sum(ss);
                const float mu = s * (1.0f / 768.0f); const float var = ss * (1.0f / 768.0f) - mu * mu;
                if (lane == 0) { st[q * 2] = mu; st[q * 2 + 1] = __builtin_amdgcn_rsqf(fmaxf(var, 0.f) + EPSV); } }
        }
        __syncthreads();
#pragma unroll
        for (int h = 0; h < 6; ++h) {
            bf16x8 wf[4]; u32x2 uu[8]; u32x4 va[4]; const float bsv = bsN;
#pragma unroll
            for (int i = 0; i < 4; ++i) { wf[i] = wfN[i]; va[i] = vaN[i]; }
#pragma unroll
            for (int i = 0; i < 8; ++i) uu[i] = uuN[i];
#pragma unroll
            for (int j = 0; j < 4; ++j) { const int item = tid + 512 * j, q = item & 127, dc = item >> 7;
                const u32x4 a = va[j];
                const float mu = st[q * 2], rs = st[q * 2 + 1];
                const float* lg = p.in[16] + h * 128 + dc * 8; const float* lb = p.in[17] + h * 128 + dc * 8;
#pragma unroll
                for (int e = 0; e < 8; ++e) { const float x = (e & 1) ? __uint_as_float(a[e >> 1] & 0xffff0000u) : __uint_as_float(a[e >> 1] << 16);
                    const float y = (x - mu) * rs * lg[e] + lb[e];
                    vnT[(dc * 8 + e) * PITCH + q] = (bf16_t)(pk2(y, 0.f) & 0xffffu); } }
            __syncthreads();
            if (h < 5) SG_LOAD(h + 1, wfN, uuN, bsN, vaN);
            const size_t tokoff = (size_t)(t0 + pp);
#pragma unroll
            for (int mt = 0; mt < 8; ++mt) { f32x4 acc = (f32x4){0.f, 0.f, 0.f, 0.f};
#pragma unroll
                for (int kk = 0; kk < 4; ++kk) { const bf16x8 af = *(const bf16x8*)(vnT + (mt * 16 + fr) * PITCH + kk * 32 + fq * 8);
                    acc = __builtin_amdgcn_mfma_f32_16x16x32_bf16(af, wf[kk], acc, 0, 0, 0); }
                const int col = h * 128 + mt * 16 + 4 * fq;
                const u32x2 u2 = uu[mt];
                const float u0 = __uint_as_float(u2.x << 16), u1 = __uint_as_float(u2.x & 0xffff0000u), u2f = __uint_as_float(u2.y << 16), u3 = __uint_as_float(u2.y & 0xffff0000u);
                u32x2 o; o.x = pk2(u0 * (acc[0] + bsv), u1 * (acc[1] + bsv)); o.y = pk2(u2f * (acc[2] + bsv), u3 * (acc[3] + bsv));
                *(u32x2*)(U + tokoff * 1024 + col) = o; }
            __syncthreads();
        }
    }
#undef SG_LOAD
}

__device__ void phase_fft1(const Params& p, unsigned char* smem) {
    const int tid = tid_opaque(), lane = tid & 63, wave = tid >> 6, fr = lane & 15, fq = lane >> 4;
    const bf16_t* P1 = (const bf16_t*)(p.ws + WS_P);
    bf16_t* Y1 = (bf16_t*)(p.ws + WS_Y1);
    const bf16_t* D1 = (const bf16_t*)(p.ws + WS_DFT1);
    bf16_t* BT = (bf16_t*)smem;
    constexpr int PITCH = 264;
    bf16x8 af[2][8];
#pragma unroll
    for (int i = 0; i < 2; ++i)
#pragma unroll
        for (int kk = 0; kk < 8; ++kk) af[i][kk] = *(const bf16x8*)(D1 + (size_t)(i * 128 + wave * 16 + fr) * 256 + kk * 32 + fq * 8);
#define F1_DECODE(u_, seq_, b_, cblk_, N2_, tokbase_) do { int rem_; \
        if ((u_) < 2048) { seq_ = (u_) >> 8; rem_ = (u_) & 255; N2_ = 64; tokbase_ = seq_ * 8192; } else { const int u2_ = (u_) - 2048; seq_ = 8 + (u2_ >> 9); rem_ = u2_ & 511; N2_ = 128; tokbase_ = T_P + (seq_ - 8) * 16384; } \
        b_ = rem_ >> 2; cblk_ = rem_ & 3; } while (0)
#define F1_LOAD(u_, V) do { int seq_, b_, cblk_, N2_, tb_; F1_DECODE(u_, seq_, b_, cblk_, N2_, tb_); \
        _Pragma("unroll") for (int j = 0; j < 4; ++j) { const int item = tid + 512 * j, a = item & 127, rest = item >> 7, part = rest >> 3, ch8 = rest & 7; \
            V[j] = *(const u32x4*)(P1 + (size_t)(tb_ + a * N2_ + b_) * 2048 + 1536 + part * 256 + cblk_ * 64 + ch8 * 8); } } while (0)
    u32x4 nx[4];
    if ((int)blockIdx.x < 3072) F1_LOAD((int)blockIdx.x, nx);
    for (int u = blockIdx.x; u < 3072; u += gridDim.x) {
        int seq, b, cblk, N2, tokbase; F1_DECODE(u, seq, b, cblk, N2, tokbase);
#pragma unroll
        for (int j = 0; j < 4; ++j) { const int item = tid + 512 * j, a = item & 127, rest = item >> 7, part = rest >> 3, ch8 = rest & 7;
            const u32x4 v = nx[j];
#pragma unroll
            for (int e = 0; e < 8; ++e) BT[(ch8 * 8 + e) * PITCH + part * 128 + a] = (bf16_t)((e & 1) ? (v[e >> 1] >> 16) : (v[e >> 1] & 0xffffu)); }
        __syncthreads();
        if (u + (int)gridDim.x < 3072) F1_LOAD(u + (int)gridDim.x, nx);
        f32x4 acc[2][4];
#pragma unroll
        for (int i = 0; i < 2; ++i)
#pragma unroll
            for (int nt = 0; nt < 4; ++nt) acc[i][nt] = (f32x4){0.f, 0.f, 0.f, 0.f};
#pragma unroll
        for (int kk = 0; kk < 8; ++kk)
#pragma unroll
            for (int nt = 0; nt < 4; ++nt) { const bf16x8 bfr = *(const bf16x8*)(BT + (nt * 16 + fr) * PITCH + kk * 32 + fq * 8);
                acc[0][nt] = __builtin_amdgcn_mfma_f32_16x16x32_bf16(bfr, af[0][kk], acc[0][nt], 0, 0, 0);
                acc[1][nt] = __builtin_amdgcn_mfma_f32_16x16x32_bf16(bfr, af[1][kk], acc[1][nt], 0, 0, 0); }
        const int ka = wave * 16 + fr, S = N2 * 128;
        const float rev = (float)((ka * b) & (S - 1)) / (float)S; const float cw = __builtin_amdgcn_cosf(rev), sw = __builtin_amdgcn_sinf(rev);
        bf16_t* yp = Y1 + (size_t)(tokbase + ka * N2 + b) * 512 + cblk * 64 + 4 * fq;
#pragma unroll
        for (int nt = 0; nt < 4; ++nt) { const f32x4 yr = acc[0][nt], yi = acc[1][nt];
            const f32x4 zr = yr * cw + yi * sw, zi = yi * cw - yr * sw;
            u32x2 o; o.x = pk2(zr[0], zr[1]); o.y = pk2(zr[2], zr[3]); *(u32x2*)(yp + nt * 16) = o;
            o.x = pk2(zi[0], zi[1]); o.y = pk2(zi[2], zi[3]); *(u32x2*)(yp + 256 + nt * 16) = o; }
        __syncthreads();
    }
#undef F1_LOAD
#undef F1_DECODE
}
__device__ void phase_fft2(const Params& p, unsigned char* smem) {
    const int tid = tid_opaque(), lane = tid & 63, wave = tid >> 6, fr = lane & 15, fq = lane >> 4;
    const bf16_t* Y1 = (const bf16_t*)(p.ws + WS_Y1);
    bf16_t* U = (bf16_t*)((unsigned char*)p.out + DO_U);
    bf16_t* BT = (bf16_t*)smem;
    constexpr int PITCH = 264;
#define F2_DECODE(u_, N2_, lg2_, tokbase_, ka_, cblk_) do { \
        if ((u_) < 4096) { N2_ = 64; lg2_ = 6; tokbase_ = ((u_) >> 9) * 8192; } else { N2_ = 128; lg2_ = 7; tokbase_ = T_P + (((u_) - 4096) >> 9) * 16384; } \
        const int rem_ = (u_) & 511; ka_ = rem_ >> 2; cblk_ = rem_ & 3; } while (0)
#define F2_LOAD(u_, V) do { int N2_, lg2_, tb_, ka_, cblk_; F2_DECODE(u_, N2_, lg2_, tb_, ka_, cblk_); \
        _Pragma("unroll") for (int j = 0; j < 4; ++j) { const int item = tid + 512 * j; if (item < N2_ * 16) { const int b = item & (N2_ - 1), rest = item >> lg2_, part = rest >> 3, ch8 = rest & 7; \
            V[j] = *(const u32x4*)(Y1 + (size_t)(tb_ + ka_ * N2_ + b) * 512 + part * 256 + cblk_ * 64 + ch8 * 8); } } } while (0)
    u32x4 nx[4];
#pragma unroll
    for (int j = 0; j < 4; ++j) nx[j] = (u32x4){0u, 0u, 0u, 0u};
    if ((int)blockIdx.x < 5120) F2_LOAD((int)blockIdx.x, nx);
    for (int u = blockIdx.x; u < 5120; u += gridDim.x) {
        int N2, lg2, tokbase, ka, cblk; F2_DECODE(u, N2, lg2, tokbase, ka, cblk);
        const bf16_t* D2 = (N2 == 128) ? (const bf16_t*)(p.ws + WS_DFT2B) : (const bf16_t*)(p.ws + WS_DFT2A);
#pragma unroll
        for (int j = 0; j < 4; ++j) { const int item = tid + 512 * j; if (item < N2 * 16) { const int b = item & (N2 - 1), rest = item >> lg2, part = rest >> 3, ch8 = rest & 7;
            const u32x4 v = nx[j];
#pragma unroll
            for (int e = 0; e < 8; ++e) BT[(ch8 * 8 + e) * PITCH + part * N2 + b] = (bf16_t)((e & 1) ? (v[e >> 1] >> 16) : (v[e >> 1] & 0xffffu)); } }
        __syncthreads();
        if (u + (int)gridDim.x < 5120) F2_LOAD(u + (int)gridDim.x, nx);
        const int nb = (N2 == 128) ? wave : (wave & 3), mt0 = (N2 == 128) ? 0 : 2 * (wave >> 2), nmt = (N2 == 128) ? 4 : 2, ksteps = N2 >> 4, K2 = 2 * N2;
        f32x4 acc[4];
#pragma unroll
        for (int i = 0; i < 4; ++i) acc[i] = (f32x4){0.f, 0.f, 0.f, 0.f};
        for (int kk = 0; kk < ksteps; ++kk) { const bf16x8 df = *(const bf16x8*)(D2 + (size_t)(nb * 16 + fr) * K2 + kk * 32 + fq * 8);
#pragma unroll
            for (int i = 0; i < 4; ++i) if (i < nmt) { const bf16x8 bfr = *(const bf16x8*)(BT + ((mt0 + i) * 16 + fr) * PITCH + kk * 32 + fq * 8);
                acc[i] = __builtin_amdgcn_mfma_f32_16x16x32_bf16(bfr, df, acc[i], 0, 0, 0); } }
        const float scale = (N2 == 128) ? 9.765625e-4f : 1.3810679e-3f;
        const int kb = nb * 16 + fr;
        bf16_t* up = U + (size_t)(tokbase + ka + 128 * kb) * 1024 + 768 + cblk * 64 + 4 * fq;
#pragma unroll
        for (int i = 0; i < 4; ++i) if (i < nmt) { const f32x4 y = acc[i] * scale; u32x2 o; o.x = pk2(y[0], y[1]); o.y = pk2(y[2], y[3]); *(u32x2*)(up + (mt0 + i) * 16) = o; }
        __syncthreads();
    }
#undef F2_LOAD
#undef F2_DECODE
}

#define XB_TMO      128
#define XB_XCNT(j)  (256  + 64 * (j))
#define XB_XSUB(j)  (1280 + 64 * (j))
#define XB_XGEN(j)  (2304 + 64 * (j))
#define XB_TOP      3328
#define XB_TOPGEN   3392
#define XCD_BAR_WORDS 3456
#define XB_SPIN_CAP (1u << 22)
__device__ __forceinline__ unsigned xb_ld(unsigned* p)              { return __hip_atomic_load(p, __ATOMIC_RELAXED, __HIP_MEMORY_SCOPE_AGENT); }
__device__ __forceinline__ unsigned xb_add(unsigned* p, unsigned v) { return __hip_atomic_fetch_add(p, v, __ATOMIC_RELAXED, __HIP_MEMORY_SCOPE_AGENT); }
__device__ __forceinline__ unsigned xb_xcc_id() { return (unsigned)__builtin_amdgcn_s_getreg((3 << 11) | 20) & 0xFu; }
#define XB_SPIN(cond, bar) do { unsigned _sp = 0; while (cond) { __builtin_amdgcn_s_sleep(1); \
    if ((++_sp & 255u) == 0u) { if (xb_ld(&(bar)[XB_TMO])) break; if (_sp > XB_SPIN_CAP) { atomicAdd(&(bar)[XB_TMO], 1u); break; } } } } while (0)
struct XcdBarrier { unsigned* bar; unsigned x; volatile LAS unsigned* st; };
__device__ __forceinline__ XcdBarrier xcd_barrier_post(unsigned* bar, volatile LAS unsigned* st) {
    XcdBarrier b; b.bar = bar; b.x = xb_xcc_id(); b.st = st;
    if (threadIdx.x == 0) (void)xb_add(&bar[XB_XCNT(b.x)], 1u);
    return b;
}
__device__ __forceinline__ void xcd_barrier_complete(unsigned* bar, unsigned x, unsigned& nloc, unsigned& nx) {
    const unsigned G = gridDim.x * gridDim.y * gridDim.z;
    unsigned sum, cnt, mine, sp = 0u;
    for (;;) {
        sum = 0u; cnt = 0u; mine = 0u;
#pragma unroll
        for (unsigned j = 0; j < 16; ++j) { const unsigned c = xb_ld(&bar[XB_XCNT(j)]); sum += c; cnt += (c > 0u) ? 1u : 0u; mine = (j == x) ? c : mine; }
        if (sum == G) break;
        __builtin_amdgcn_s_sleep(1);
        if ((++sp & 255u) == 0u) { if (xb_ld(&bar[XB_TMO])) break; if (sp > XB_SPIN_CAP) { atomicAdd(&bar[XB_TMO], 1u); break; } }
    }
    nloc = mine > 0u ? mine : 1u; nx = cnt > 0u ? cnt : 1u;
}
__device__ __forceinline__ void xcd_barrier(const XcdBarrier& b) {
    asm volatile("s_waitcnt vmcnt(0)" ::: "memory");
    __syncthreads();
    if (threadIdx.x == 0) {
        unsigned* bar = b.bar;
        __builtin_amdgcn_s_waitcnt(0);
        unsigned nloc = b.st[0], nx = b.st[1];
        if (nloc == 0u) { xcd_barrier_complete(bar, b.x, nloc, nx); b.st[0] = nloc; b.st[1] = nx; }
        const unsigned old = xb_add(&bar[XB_XSUB(b.x)], 1u);
        const unsigned gen = old / nloc;
        if (old + 1u == (gen + 1u) * nloc) {
            __builtin_amdgcn_fence(__ATOMIC_RELEASE, "agent");
            asm volatile("s_waitcnt vmcnt(0)" ::: "memory");
            const unsigned og = xb_add(&bar[XB_TOP], 1u);
            const unsigned tg = og / nx;
            if (og + 1u == (tg + 1u) * nx) xb_add(&bar[XB_TOPGEN], 1u);
            else XB_SPIN(xb_ld(&bar[XB_TOPGEN]) == tg, bar);
            __builtin_amdgcn_fence(__ATOMIC_ACQUIRE, "agent");
            xb_add(&bar[XB_XGEN(b.x)], 1u);
            asm volatile("s_waitcnt vmcnt(0)" ::: "memory");
        } else {
            XB_SPIN(xb_ld(&bar[XB_XGEN(b.x)]) == gen, bar);
            __builtin_amdgcn_fence(__ATOMIC_ACQUIRE, "agent");
            asm volatile("s_waitcnt vmcnt(0)" ::: "memory");
        }
    }
    __syncthreads();
}

__device__ __forceinline__ int opaque(int v) { int r; asm volatile("s_mov_b32 %0, %1" : "=s"(r) : "s"(v)); return r; }
__global__ void __launch_bounds__(512, 2) fwd_mega(Params p) {
    extern __shared__ __attribute__((aligned(16))) unsigned char smem[];
    cg::grid_group grid = cg::this_grid();
    LAS unsigned char* lds = (LAS unsigned char*)smem;
    unsigned char* ws = p.ws;
    const int lo = p.ph_lo, hi = p.ph_hi, G = gridDim.x, bid = blockIdx.x;
    const float* mod = (const float*)(ws + WS_MOD);
    bf16_t* H = (bf16_t*)(ws + WS_H);
    bf16_t* P = (bf16_t*)(ws + WS_P);
    float* out = p.out;
    bf16_t* U = (bf16_t*)((unsigned char*)p.out + DO_U);
    bf16_t* X = H;
    float* rowpart = (float*)(ws + WS_RP);
    const float* biasb = (const float*)(ws + WS_BIAS);
    bool first = true;
    volatile LAS unsigned* xst = (volatile LAS unsigned*)(lds + 131072);
    if (threadIdx.x == 0) { xst[0] = 0u; xst[1] = 0u; }
    __syncthreads();
    XcdBarrier xbar = xcd_barrier_post((unsigned*)(ws + WS_BAR), xst);
    int nseam = 0;
#if PROBE_SYNCS
    for (int i = 0; i < PROBE_SYNCS; ++i) grid.sync();
#endif
#pragma unroll 1
    for (int ph = lo; ph < hi; ++ph) {
        if (ph == 5 || ph == 8 || ph == 13) continue;
#if PROBE_MASK
        for (int rep = 0; rep < (((PROBE_MASK >> ph) & 1) ? 2 : 1); ++rep) {
#endif
        if (!first) { if (nseam == 0) grid.sync(); else xcd_barrier(xbar); ++nseam; }
        first = false;
        const int l = ph >= 8 ? 1 : 0;
        const float* modl = mod + (size_t)l * 61440;
        if (ph == 0) phase_prep(p, smem);
        else if (ph == 1) { phase_wscaled(p, smem); phase_bias(p, smem); phase_norm(p.in[0], p.in[1], mod, 1, 0, H); }
        else if (ph == 2) { pg8::Gemm g{H, (const bf16_t*)(ws + WS_WAB_IN), T_TOK, opaque(2560), opaque(1024), 0}; pg8::StaticOrder S; S.init(T_TOK, g.N, G, bid);
            EpiAct<0> E{P, 1536, nullptr, nullptr, 0}; pg8::gemm_phase<EpiAct<0>, pg8::StaticOrder>(lds, g, S, E); }
#if PROBE_HOT
        else if (ph == 3) { { struct HotOrder : pg8::StaticOrder { __device__ bool next(int i, Unit& u) const { if (!pg8::StaticOrder::next(i, u)) return false; u.pm = 0; u.pn = u.pn % PROBE_HOT; return true; } };
            pg8::Gemm g{H, (const bf16_t*)(ws + WS_WAB_IN), T_TOK, opaque(2560), opaque(1024), 0}; HotOrder S; S.init(T_TOK, g.N, G, bid);
            EpiAct<2> E{(bf16_t*)(ws + WS_END), 2560, nullptr, nullptr, 0}; pg8::gemm_phase<EpiAct<2>, HotOrder>(lds, g, S, E); }
            grid.sync(); phase_conv(p, smem); }
#else
        else if (ph == 3) phase_conv(p, smem);
#endif
        else if (ph == 4) { pg8::Gemm g{U, (const bf16_t*)(ws + WS_WAB_OUT), T_TOK, opaque(1024), opaque(1024), 0}; pg8::StaticOrder S; S.init(T_TOK, g.N, G, bid);
            EpiRes<true> E{p.in[0], p.in[1], X, mod + 2 * 1024, rowpart}; pg8::gemm_phase<EpiRes<true>, pg8::StaticOrder>(lds, g, S, E); }
        else if (ph == 7 || ph == 12 || ph == 15) {
            const bool ffn = (ph != 12);
            const bf16_t* A = ffn ? P : U;
            const bf16_t* Bt = ph == 12 ? (const bf16_t*)(ws + WS_WCD_OUT) : (const bf16_t*)(ws + WS_WFFN_OUT) + (size_t)l * 1024 * 2816;
            pg8::Gemm g{A, Bt, T_TOK, opaque(1024), opaque(ffn ? DFF : 1024), 0}; pg8::StaticOrder S; S.init(T_TOK, g.N, G, bid);
            const int ri = ph == 7 ? 1 : ph == 12 ? 2 : 3;
            EpiRes<false> E{nullptr, nullptr, X, modl + (ffn ? 5 : 2) * 1024, rowpart + (size_t)ri * T_TOK * 16};
            pg8::gemm_phase<EpiRes<false>, pg8::StaticOrder>(lds, g, S, E);
        }
        else if (ph == 6 || ph == 14) { const bf16_t* Bt = l == 0 ? (const bf16_t*)(ws + WS_WF0) : (const bf16_t*)((unsigned char*)p.out + DO_WF1);
            pg8::Gemm g{X, Bt, T_TOK, opaque(5632), opaque(1024), (size_t)5632 * 1024 * 2}; pg8::StaticOrder S; S.init(T_TOK, g.N, G, bid);
            EpiAct<1> E{P, DFF, rowpart + (size_t)(l == 0 ? 0 : 2) * T_TOK * 16, biasb + (l == 0 ? 0 : 56320 + 20480), 5632}; pg8::gemm_phase<EpiAct<1>, pg8::StaticOrder>(lds, g, S, E); }
        else if (ph == 9) { pg8::Gemm g{X, (const bf16_t*)((unsigned char*)p.out + DO_WCD), T_TOK, opaque(2048), opaque(1024), (size_t)2048 * 1024 * 2}; pg8::StaticOrder S; S.init(T_TOK, g.N, G, bid);
            EpiAct<2> E{P, 2048, rowpart + (size_t)1 * T_TOK * 16, biasb + 56320, 2048}; pg8::gemm_phase<EpiAct<2>, pg8::StaticOrder>(lds, g, S, E); }
#if PROBE_SG
        else if (ph == 10) { phase_sg(p, smem); __syncthreads(); phase_sg(p, smem); __syncthreads(); phase_fft1(p, smem); }
#else
        else if (ph == 10) { phase_sg(p, smem); __syncthreads(); phase_fft1(p, smem); }
#endif
        else if (ph == 11) phase_fft2(p, smem);
        else if (ph == 16) phase_final(out, X, rowpart + (size_t)3 * T_TOK * 16, p.in[23]);
#if PROBE_MASK
        }
#endif
    }
}

#ifndef N_LAUNCH_SPLIT
#define N_LAUNCH_SPLIT 0
#endif
extern "C" void kernel_launch(void* const* d_in, const int* in_sizes, int n_in, void* d_out, int out_size, void* d_ws, size_t ws_size, hipStream_t stream) {
    static int grid = 0;
    if (grid == 0) {
        if (n_in != 24 || ws_size < WS_END) { fprintf(stderr, "kernel_launch: unexpected n_in %d or ws_size %zu (need %zu)\n", n_in, ws_size, (size_t)WS_END); grid = -1; return; }
        int dev = 0, cus = 0, per_cu = 0;
        hipGetDevice(&dev);
        hipDeviceGetAttribute(&cus, hipDeviceAttributeMultiprocessorCount, dev);
        if (hipFuncSetAttribute((const void*)fwd_mega, hipFuncAttributeMaxDynamicSharedMemorySize, LDS_BYTES) != hipSuccess) { fprintf(stderr, "kernel_launch: hipFuncSetAttribute failed\n"); grid = -1; return; }
        if (hipOccupancyMaxActiveBlocksPerMultiprocessor(&per_cu, (const void*)fwd_mega, 512, LDS_BYTES) != hipSuccess || per_cu < 1) { fprintf(stderr, "kernel_launch: occupancy query says %d\n", per_cu); per_cu = 1; }
        (void)hipGetLastError();
        grid = cus;
        if (grid > 256) grid = 256;
    }
    if (grid < 0) return;
    Params p{};
    for (int i = 0; i < 24; ++i) p.in[i] = (const float*)d_in[i];
    p.out = (float*)d_out; p.ws = (unsigned char*)d_ws;
#if N_LAUNCH_SPLIT
    for (int ph = 0; ph < 17; ++ph) { p.ph_lo = ph; p.ph_hi = ph + 1; void* args[] = {&p};
        hipError_t e = hipLaunchCooperativeKernel((const void*)fwd_mega, dim3(grid), dim3(512), args, LDS_BYTES, stream);
        if (e != hipSuccess) { fprintf(stderr, "cooperative launch failed: %s (grid %d)\n", hipGetErrorString(e), grid); break; } }
#else
    if (hipMemsetAsync((char*)d_ws + WS_BAR, 0, 16384, stream) != hipSuccess) { fprintf(stderr, "kernel_launch: memset of barrier words failed\n"); return; }
    p.ph_lo = 0; p.ph_hi = 17; void* args[] = {&p};
    hipError_t e = hipLaunchCooperativeKernel((const void*)fwd_mega, dim3(grid), dim3(512), args, LDS_BYTES, stream);
    if (e != hipSuccess) fprintf(stderr, "cooperative launch failed: %s (grid %d)\n", hipGetErrorString(e), grid);
#endif
}
```

```cpp
#include <hip/hip_runtime.h>
#include <hip/hip_cooperative_groups.h>
#include <cstdio>
namespace cg = cooperative_groups;

namespace pg8 {
#define PG8_LAS __attribute__((address_space(3)))
typedef unsigned short bf16_t;
typedef short bf16x8 __attribute__((ext_vector_type(8)));
typedef float f32x4 __attribute__((ext_vector_type(4)));
typedef unsigned u32x4 __attribute__((ext_vector_type(4)));
constexpr int BM = 256, BK = 64, HALF = 128, HTB = HALF * BK * 2  , STAGE_BYTES = 8 * HTB, NXCD = 8, WGM = 8;

__host__ __device__ __forceinline__ int lds_byte(int r, int c) { const int st = (r >> 4) * 2 + (c >> 5), rr = r & 15, cc = c & 31, ob = rr * 64 + cc * 2; return st * 1024 + (ob ^ (((ob >> 9) & 1) << 5)); }
__host__ __device__ __forceinline__ void stage_rc(int b, int& R, int& C) { const int st = b / 1024, sb = b % 1024, swz = sb ^ (((sb >> 9) & 1) << 5); R = (st >> 1) * 16 + swz / 64; C = (st & 1) * 32 + (swz % 64) / 2; }
__host__ __device__ __forceinline__ int perm32(int rho) { const int n = rho >> 4, i = rho & 15; return 8 * (i >> 2) + 4 * n + (i & 3); }

struct Unit { int pm, pn; };
struct Gemm { const bf16_t* A; const bf16_t* Bt; int M, N, K; size_t bseq; };
__device__ __forceinline__ int seq_of_pm(int pm) { return pm < 256 ? (pm >> 5) : 8 + ((pm - 256) >> 6); }

struct StaticOrder {
    int nM, nN, nwg, G, c;
    __host__ __device__ void init(int M, int N, int G_, int c_) { nM = M / BM; nN = N / BM; nwg = nM * nN; G = G_; c = c_; }
    __host__ __device__ bool next(int i, Unit& u) const {
        const long L = (long)i * G + c; if (L >= nwg) return false;
        int wgid = (int)L; { const int q = nwg / NXCD, r = nwg % NXCD, xcd = wgid % NXCD, off = wgid / NXCD; wgid = (xcd < r ? xcd * (q + 1) : r * (q + 1) + (xcd - r) * q) + off; }
        const int nig = WGM * nN, gid = wgid / nig, fm = gid * WGM, gsz = (nM - fm) < WGM ? (nM - fm) : WGM;
        u.pm = fm + ((wgid % nig) % gsz); u.pn = (wgid % nig) / gsz; return true;
    }
    __device__ __forceinline__ void a_ready(const Unit&) const {}
    __device__ __forceinline__ void done(const Unit&) const {}
};
__device__ __forceinline__ unsigned cvt_pk_bf16(float lo, float hi) { unsigned r; asm volatile("v_cvt_pk_bf16_f32 %0, %1, %2" : "=v"(r) : "v"(lo), "v"(hi)); return r; }
template <class Epi, class Sched>
__device__ __forceinline__ void gemm_phase(PG8_LAS unsigned char* lds, const Gemm g, const Sched& S, const Epi& E) {
    int tid = threadIdx.x; asm volatile("" : "+v"(tid)); const int wid = __builtin_amdgcn_readfirstlane(tid >> 6), lane = tid & 63, wr = wid >> 2, wc = wid & 3, fr = lane & 15, fq = lane >> 4;
    const int K = g.K, nt = K / BK;
    unsigned voffA[2], voffB[2];
#pragma unroll
    for (int i = 0; i < 2; ++i) { int R, C; stage_rc(tid * 16 + i * 8192, R, C); const int Rb = Epi::PERM ? ((R & ~31) + perm32(R & 31)) : R;
        voffA[i] = (unsigned)(R * K + C) * 2u; voffB[i] = (unsigned)(Rb * K + C) * 2u; }
    const size_t kstep = (size_t)(BK * 2);
    const size_t hstep = (size_t)HALF * K * 2;
    const size_t tstep = 2 * hstep;
    const unsigned ldsw = (unsigned)wid * 1024u;
    const int aoff = lds_byte(wr * 64 + fr, fq * 8), boff = lds_byte(wc * 32 + fr, fq * 8);
#define PG8_SA(b, h) (((b) * 2 + (h)) * HTB)
#define PG8_SB(b, h) ((4 + (b) * 2 + (h)) * HTB)
#define PG8_STAGE(bufoff, gbase, voff, AUX) do { _Pragma("unroll") for (int _i = 0; _i < 2; ++_i) \
        __builtin_amdgcn_global_load_lds((const unsigned*)((const char*)(gbase) + (voff)[_i]), (PG8_LAS unsigned*)(lds + (bufoff) + ldsw + _i * 8192), 16, 0, AUX); } while (0)
#define PG8_LDA(dst, b, h) do { _Pragma("unroll") for (int m = 0; m < 4; ++m) _Pragma("unroll") for (int k = 0; k < 2; ++k) dst[m][k] = *(const PG8_LAS bf16x8*)(lds + PG8_SA(b, h) + aoff + m * 2048 + k * 1024); } while (0)
#define PG8_LDB(dst, b, h) do { _Pragma("unroll") for (int n = 0; n < 2; ++n) _Pragma("unroll") for (int k = 0; k < 2; ++k) dst[n][k] = *(const PG8_LAS bf16x8*)(lds + PG8_SB(b, h) + boff + n * 2048 + k * 1024); } while (0)
#define PG8_MMA(ai, bj, At, Bt) do { __builtin_amdgcn_s_setprio(1); _Pragma("unroll") for (int m = 0; m < 4; ++m) _Pragma("unroll") for (int n = 0; n < 2; ++n) _Pragma("unroll") for (int k = 0; k < 2; ++k) \
        acc[ai][bj][m][n] = __builtin_amdgcn_mfma_f32_16x16x32_bf16(Bt[n][k], At[m][k], acc[ai][bj][m][n], 0, 0, 0); __builtin_amdgcn_s_setprio(0); } while (0)
#define PG8_WAIT_V(n) asm volatile("s_waitcnt vmcnt(" #n ")" ::: "memory")
#define PG8_WAIT_L(n) asm volatile("s_waitcnt lgkmcnt(" #n ")" ::: "memory")
#define PG8_BAR __builtin_amdgcn_s_barrier()
#define PG8_SCHED __builtin_amdgcn_sched_barrier(0)
    Unit cur, nxt; int ui = 0;
    if (!S.next(0, cur)) return;
    f32x4 acc[2][2][4][2];
#pragma unroll
    for (int a = 0; a < 2; ++a)
#pragma unroll
        for (int b = 0; b < 2; ++b)
#pragma unroll
            for (int m = 0; m < 4; ++m)
#pragma unroll
                for (int n = 0; n < 2; ++n) acc[a][b][m][n] = (f32x4){0.f, 0.f, 0.f, 0.f};
    bf16x8 At[4][2], B0[2][2], B1[2][2];
    const char* cA = (const char*)g.A + (size_t)cur.pm * tstep; const char* cB = (const char*)g.Bt + (size_t)cur.pn * tstep + (size_t)seq_of_pm(cur.pm) * g.bseq;
    S.a_ready(cur);
    PG8_STAGE(PG8_SB(0, 0), cB, voffB, Epi::B_AUX); PG8_STAGE(PG8_SA(0, 0), cA, voffA, Epi::A_AUX); PG8_STAGE(PG8_SB(0, 1), cB + hstep, voffB, Epi::B_AUX); PG8_STAGE(PG8_SA(0, 1), cA + hstep, voffA, Epi::A_AUX);
    if (wr == 1) PG8_BAR;
    PG8_WAIT_V(4); PG8_BAR;
    PG8_STAGE(PG8_SB(1, 0), cB + kstep, voffB, Epi::B_AUX); PG8_STAGE(PG8_SA(1, 0), cA + kstep, voffA, Epi::A_AUX); PG8_STAGE(PG8_SB(1, 1), cB + hstep + kstep, voffB, Epi::B_AUX);
    PG8_WAIT_V(6); PG8_BAR;
    for (;;) {
        const bool has_next = S.next(ui + 1, nxt);
        const char* nA = has_next ? (const char*)g.A + (size_t)nxt.pm * tstep : cA; const char* nB = has_next ? (const char*)g.Bt + (size_t)nxt.pn * tstep + (size_t)seq_of_pm(nxt.pm) * g.bseq : cB;
        for (int t = 0; t < nt; t += 2) {
            const bool last = (t == nt - 2);
            const char* a1 = cA + (size_t)(t + 1) * kstep;
            const char* a2 = last ? nA : cA + (size_t)(t + 2) * kstep; const char* b2 = last ? nB : cB + (size_t)(t + 2) * kstep;
            const char* a3 = a2 + kstep; const char* b3 = b2 + kstep;
            if (last && has_next) S.a_ready(nxt);
            PG8_LDB(B0, 0, 0); PG8_SCHED; PG8_LDA(At, 0, 0); PG8_STAGE(PG8_SA(1, 1), a1 + hstep, voffA, Epi::A_AUX);
            PG8_WAIT_L(8); PG8_BAR; PG8_WAIT_L(0); PG8_MMA(0, 0, At, B0); PG8_BAR; PG8_SCHED;
            PG8_LDB(B1, 0, 1); PG8_STAGE(PG8_SB(0, 0), b2, voffB, Epi::B_AUX);
            PG8_BAR; PG8_WAIT_L(0); PG8_MMA(0, 1, At, B1); PG8_BAR;
            PG8_LDA(At, 0, 1); PG8_STAGE(PG8_SA(0, 0), a2, voffA, Epi::A_AUX);
            PG8_BAR; PG8_WAIT_L(0); PG8_MMA(1, 0, At, B0); PG8_BAR; PG8_SCHED;
            PG8_STAGE(PG8_SB(0, 1), b2 + hstep, voffB, Epi::B_AUX);
            PG8_WAIT_V(6); PG8_BAR; PG8_MMA(1, 1, At, B1); PG8_BAR;
            PG8_LDB(B0, 1, 0); PG8_SCHED; PG8_LDA(At, 1, 0); PG8_STAGE(PG8_SA(0, 1), a2 + hstep, voffA, Epi::A_AUX);
            PG8_WAIT_L(8); PG8_BAR; PG8_WAIT_L(0); PG8_MMA(0, 0, At, B0); PG8_BAR; PG8_SCHED;
            PG8_LDB(B1, 1, 1); PG8_STAGE(PG8_SB(1, 0), b3, voffB, Epi::B_AUX);
            PG8_BAR; PG8_WAIT_L(0); PG8_MMA(0, 1, At, B1); PG8_BAR;
            PG8_LDA(At, 1, 1); PG8_STAGE(PG8_SA(1, 0), a3, voffA, Epi::A_AUX);
            PG8_BAR; PG8_WAIT_L(0); PG8_MMA(1, 0, At, B0); PG8_BAR; PG8_SCHED;
            PG8_STAGE(PG8_SB(1, 1), b3 + hstep, voffB, Epi::B_AUX);
            PG8_WAIT_V(6); PG8_BAR; PG8_MMA(1, 1, At, B1); PG8_BAR;
        }
        if constexpr (!Epi::AFTER_DRAIN) { E(acc, cur, wr, wc, fr, fq); S.done(cur); }
        if (!has_next) break;
#pragma unroll
        for (int a = 0; a < 2; ++a)
#pragma unroll
            for (int b = 0; b < 2; ++b)
#pragma unroll
                for (int m = 0; m < 4; ++m)
#pragma unroll
                    for (int n = 0; n < 2; ++n) acc[a][b][m][n] = (f32x4){0.f, 0.f, 0.f, 0.f};
        cur = nxt; cA = nA; cB = nB; ++ui;
    }
    PG8_WAIT_V(0);
    if (wr == 0) PG8_BAR;
    PG8_BAR;
    if constexpr (Epi::AFTER_DRAIN) { E.fused(acc, cur, wr, wc, fr, fq, lds, wid, lane); S.done(cur); }
#undef PG8_SA
#undef PG8_SB
#undef PG8_STAGE
#undef PG8_LDA
#undef PG8_LDB
#undef PG8_MMA
#undef PG8_WAIT_V
#undef PG8_WAIT_L
#undef PG8_BAR
#undef PG8_SCHED
}
}


using pg8::bf16_t; using pg8::bf16x8; using pg8::f32x4; using pg8::u32x4; using pg8::Unit;
typedef unsigned u32x2 __attribute__((ext_vector_type(2)));
#define LAS PG8_LAS
constexpr int T_TOK = 98304, T_P = 65536, DM = 1024, DFF = 2816;
constexpr int LDS_BYTES = 131072 + 16;
constexpr float EPSV = 1e-6f;

constexpr size_t WS_WAB_IN = 0;
constexpr size_t WS_WAB_OUT = WS_WAB_IN + (size_t)2560 * 1024 * 2;
constexpr size_t WS_WCD_IN = WS_WAB_OUT + (size_t)1024 * 1024 * 2;
constexpr size_t WS_WCD_OUT = WS_WCD_IN + (size_t)2048 * 1024 * 2;
constexpr size_t WS_WFFN_IN = WS_WCD_OUT + (size_t)1024 * 1024 * 2;
constexpr size_t WS_WFFN_OUT = WS_WFFN_IN + (size_t)2 * 5632 * 1024 * 2;
constexpr size_t WS_WS = WS_WFFN_OUT + (size_t)2 * 1024 * 2816 * 2;
constexpr size_t WS_MOD = WS_WS + (size_t)6 * 128 * 128 * 2;
constexpr size_t WS_DFT1 = WS_MOD + (size_t)2 * 10 * 6144 * 4;
constexpr size_t WS_DFT2A = WS_DFT1 + (size_t)256 * 256 * 2;
constexpr size_t WS_DFT2B = WS_DFT2A + (size_t)64 * 128 * 2;
constexpr size_t WS_H = WS_DFT2B + (size_t)128 * 256 * 2;
constexpr size_t WS_P = WS_H + (size_t)T_TOK * 1024 * 2;
constexpr size_t WS_Y1 = WS_P + (size_t)T_TOK * 2048 * 2;
constexpr size_t WS_RP = WS_P + (size_t)T_TOK * 2816 * 2;
constexpr size_t WS_BIAS = WS_RP + (size_t)4 * T_TOK * 16 * 4;
constexpr size_t WS_WF0 = WS_BIAS + (size_t)10 * (5632 + 2048 + 5632) * 4;
constexpr size_t WS_BAR = WS_WF0 + (size_t)10 * 5632 * 1024 * 2;
constexpr size_t WS_END = WS_BAR + 16384;
constexpr size_t DO_U = 0;
constexpr size_t DO_WCD = DO_U + (size_t)T_TOK * 1024 * 2;
constexpr size_t DO_WF1 = DO_WCD + (size_t)10 * 2048 * 1024 * 2;
constexpr size_t DO_END = DO_WF1 + (size_t)10 * 5632 * 1024 * 2;
static_assert(DO_END <= (size_t)T_TOK * 1024 * 4, "d_out scratch overflow");

#ifndef PROBE_SYNCS
#define PROBE_SYNCS 0
#endif
#ifndef PROBE_SG
#define PROBE_SG 0
#endif
#ifndef PROBE_HOT
#define PROBE_HOT 0
#endif
#ifndef PROBE_MASK
#define PROBE_MASK 0
#endif
struct Params { const float* in[24]; float* out; unsigned char* ws; int ph_lo, ph_hi; };

__device__ __forceinline__ int tid_opaque() { int t = threadIdx.x; asm volatile("" : "+v"(t)); return t; }
__device__ __forceinline__ int seq_of(int row) { return row < T_P ? (row >> 13) : 8 + ((row - T_P) >> 14); }
__device__ __forceinline__ float bf2f(unsigned short b) { return __uint_as_float(((unsigned)b) << 16); }
__device__ __forceinline__ unsigned pk2(float lo, float hi) { return pg8::cvt_pk_bf16(lo, hi); }
__device__ __forceinline__ float sigm(float x) { return __builtin_amdgcn_rcpf(1.0f + __builtin_amdgcn_exp2f(-1.44269504f * x)); }
__device__ __forceinline__ float wave_sum(float v) {
#pragma unroll
    for (int o = 32; o >= 1; o >>= 1) v += __shfl_xor(v, o);
    return v;
}

template <int KIND> struct EpiAct {
    static constexpr bool PERM = true, AFTER_DRAIN = false; static constexpr int A_AUX = 0, B_AUX = 0;
    bf16_t* O; int ldc; const float* rowpart; const float* bias; int nbias;
    __device__ __forceinline__ void operator()(const f32x4 (&acc)[2][2][4][2], const Unit& u, int wr, int wc, int fr, int fq) const {
        asm volatile("" : "+v"(fr), "+v"(fq));
        const int row0 = u.pm * 256 + wr * 64 + fr;
        float rs[2][4]; f32x4 bv[2][2];
        if (rowpart) {
#pragma unroll
            for (int ai = 0; ai < 2; ++ai)
#pragma unroll
                for (int m = 0; m < 4; ++m) { const f32x4 pv = *(const f32x4*)(rowpart + (size_t)(row0 + ai * 128 + m * 16) * 16 + 4 * fq);
                    float ss = (pv[0] + pv[1]) + (pv[2] + pv[3]); ss += __shfl_xor(ss, 16); ss += __shfl_xor(ss, 32);
                    rs[ai][m] = __builtin_amdgcn_rsqf(ss * (1.0f / 1024.0f) + EPSV); }
            const float* bp = bias + (size_t)seq_of(u.pm * 256) * nbias + u.pn * 256 + wc * 32 + 8 * fq;
#pragma unroll
            for (int bj = 0; bj < 2; ++bj)
#pragma unroll
                for (int n = 0; n < 2; ++n) bv[bj][n] = *(const f32x4*)(bp + bj * 128 + 4 * n);
        } else {
#pragma unroll
            for (int ai = 0; ai < 2; ++ai)
#pragma unroll
                for (int m = 0; m < 4; ++m) rs[ai][m] = 1.0f;
#pragma unroll
            for (int bj = 0; bj < 2; ++bj)
#pragma unroll
                for (int n = 0; n < 2; ++n) bv[bj][n] = (f32x4){0.f, 0.f, 0.f, 0.f};
        }
        int mode, colbase;
        if (KIND == 2) { mode = 0; colbase = u.pn * 256; }
        else if (KIND == 1) { mode = 3; colbase = u.pn * 128; }
        else { if (u.pn < 2) { mode = 0; colbase = u.pn * 256; } else if (u.pn < 6) { mode = 1; colbase = 512 + (u.pn - 2) * 128; } else { mode = 2; colbase = 1024 + (u.pn - 6) * 128; } }
        const int col0 = colbase + wc * 32 + 8 * fq;
#pragma unroll
        for (int ai = 0; ai < 2; ++ai)
#pragma unroll
            for (int m = 0; m < 4; ++m) { bf16_t* rowp = O + (size_t)(row0 + ai * 128 + m * 16) * ldc + col0;
                const float sc = rs[ai][m];
                const f32x4 a0 = acc[ai][0][m][0] * sc + bv[0][0], a1 = acc[ai][0][m][1] * sc + bv[0][1], b0 = acc[ai][1][m][0] * sc + bv[1][0], b1 = acc[ai][1][m][1] * sc + bv[1][1];
                if (mode == 0) {
                    u32x4 w; w.x = pk2(a0[0], a0[1]); w.y = pk2(a0[2], a0[3]); w.z = pk2(a1[0], a1[1]); w.w = pk2(a1[2], a1[3]);
                    __builtin_nontemporal_store(w, (u32x4*)rowp);
                    w.x = pk2(b0[0], b0[1]); w.y = pk2(b0[2], b0[3]); w.z = pk2(b1[0], b1[1]); w.w = pk2(b1[2], b1[3]);
                    __builtin_nontemporal_store(w, (u32x4*)(rowp + 128));
                } else {
                    float r[8];
#pragma unroll
                    for (int j = 0; j < 4; ++j) {
                        if (mode == 1) { r[j] = a0[j] * b0[j]; r[4 + j] = a1[j] * b1[j]; }
                        else if (mode == 2) { r[j] = a0[j] * sigm(b0[j]); r[4 + j] = a1[j] * sigm(b1[j]); }
                        else { r[j] = a0[j] * sigm(a0[j]) * b0[j]; r[4 + j] = a1[j] * sigm(a1[j]) * b1[j]; } }
                    u32x4 w; w.x = pk2(r[0], r[1]); w.y = pk2(r[2], r[3]); w.z = pk2(r[4], r[5]); w.w = pk2(r[6], r[7]);
                    __builtin_nontemporal_store(w, (u32x4*)rowp); }
            }
    }
};
#ifndef RES_A_AUX
#define RES_A_AUX 0
#endif
template <bool SRC_F32> struct EpiRes {
    static constexpr bool PERM = true, AFTER_DRAIN = false; static constexpr int A_AUX = RES_A_AUX, B_AUX = 0;
    const float* src0; const float* src1; bf16_t* X; const float* gate; float* rowpart;
    __device__ __forceinline__ void operator()(const f32x4 (&acc)[2][2][4][2], const Unit& u, int wr, int wc, int fr, int fq) const {
        asm volatile("" : "+v"(fr), "+v"(fq));
        const int rowl = wr * 64 + fr, col0 = u.pn * 256 + wc * 32 + 8 * fq, rbase = u.pm * 256;
        const int seq = seq_of(rbase);
        const float* gp = gate + (size_t)seq * 6144 + col0;
        f32x4 gv[2][2];
#pragma unroll
        for (int bj = 0; bj < 2; ++bj)
#pragma unroll
            for (int n = 0; n < 2; ++n) gv[bj][n] = *(const f32x4*)(gp + bj * 128 + 4 * n);
        bf16_t* xb = X + (size_t)rbase * 1024 + col0;
        const float* sb = (rbase < T_P) ? src0 + (size_t)rbase * 1024 + col0 : src1 + (size_t)(rbase - T_P) * 1024 + col0;
#pragma unroll
        for (int ai = 0; ai < 2; ++ai) {
            f32x4 sv[4][2][2];
            if (SRC_F32) {
#pragma unroll
                for (int m = 0; m < 4; ++m)
#pragma unroll
                    for (int bj = 0; bj < 2; ++bj)
#pragma unroll
                        for (int n = 0; n < 2; ++n) sv[m][bj][n] = *(const f32x4*)(sb + (size_t)(rowl + ai * 128 + m * 16) * 1024 + bj * 128 + 4 * n);
            } else {
                u32x4 raw[4][2];
#pragma unroll
                for (int m = 0; m < 4; ++m)
#pragma unroll
                    for (int bj = 0; bj < 2; ++bj) raw[m][bj] = *(const u32x4*)(xb + (size_t)(rowl + ai * 128 + m * 16) * 1024 + bj * 128);
#pragma unroll
                for (int m = 0; m < 4; ++m)
#pragma unroll
                    for (int bj = 0; bj < 2; ++bj) { const u32x4 r = raw[m][bj];
                        sv[m][bj][0] = (f32x4){__uint_as_float(r.x << 16), __uint_as_float(r.x & 0xffff0000u), __uint_as_float(r.y << 16), __uint_as_float(r.y & 0xffff0000u)};
                        sv[m][bj][1] = (f32x4){__uint_as_float(r.z << 16), __uint_as_float(r.z & 0xffff0000u), __uint_as_float(r.w << 16), __uint_as_float(r.w & 0xffff0000u)}; }
            }
#pragma unroll
            for (int m = 0; m < 4; ++m) { const int rl = rowl + ai * 128 + m * 16; float ss = 0.f;
#pragma unroll
                for (int bj = 0; bj < 2; ++bj) { const f32x4 x0 = sv[m][bj][0] + gv[bj][0] * acc[ai][bj][m][0], x1 = sv[m][bj][1] + gv[bj][1] * acc[ai][bj][m][1];
                    ss += (x0[0] * x0[0] + x0[1] * x0[1]) + (x0[2] * x0[2] + x0[3] * x0[3]) + (x1[0] * x1[0] + x1[1] * x1[1]) + (x1[2] * x1[2] + x1[3] * x1[3]);
                    u32x4 w; w.x = pk2(x0[0], x0[1]); w.y = pk2(x0[2], x0[3]); w.z = pk2(x1[0], x1[1]); w.w = pk2(x1[2], x1[3]);
                    *(u32x4*)(xb + (size_t)rl * 1024 + bj * 128) = w; }
                ss += __shfl_xor(ss, 16); ss += __shfl_xor(ss, 32);
                if (fq == 0) rowpart[(size_t)(rbase + rl) * 16 + u.pn * 4 + wc] = ss; }
            asm volatile("" ::: "memory");
        }
    }
};

__device__ __forceinline__ int map_ab(int n0) {
    if (n0 < 512) return n0;
    if (n0 < 1536) { const int q = (n0 - 512) >> 8, r = (n0 - 512) & 255; return r < 128 ? 512 + 128 * q + r : 1024 + 128 * q + (r - 128); }
    const int q = (n0 - 1536) >> 8, r = (n0 - 1536) & 255; return r < 128 ? 1536 + 128 * q + r : 2048 + 128 * q + (r - 128);
}
__device__ __forceinline__ int map_ffn(int n0) { const int q = n0 >> 8, r = n0 & 255; return r < 128 ? 128 * q + r : 2816 + 128 * q + (r - 128); }

__device__ __forceinline__ void tile_load(const float* __restrict__ src, int ld, int c0, int k0, float* tile) {
    const int tid = tid_opaque();
#pragma unroll
    for (int p = 0; p < 2; ++p) { const int r = (tid >> 4) + p * 32, c4 = (tid & 15) * 4;
        const f32x4 v = *(const f32x4*)(src + (size_t)(k0 + r) * ld + c0 + c4);
        float* t = tile + r * 65 + c4; t[0] = v[0]; t[1] = v[1]; t[2] = v[2]; t[3] = v[3]; }
}
__device__ __forceinline__ void tile_store_t(const float* tile, bf16_t* __restrict__ dst, int ldd, int n0, int k0) {
    const int tid = tid_opaque(), n = tid >> 3, k8 = (tid & 7) * 8;
    float f[8];
#pragma unroll
    for (int i = 0; i < 8; ++i) f[i] = tile[(k8 + i) * 65 + n];
    u32x4 w; w.x = pk2(f[0], f[1]); w.y = pk2(f[2], f[3]); w.z = pk2(f[4], f[5]); w.w = pk2(f[6], f[7]);
    *(u32x4*)(dst + (size_t)(n0 + n) * ldd + k0 + k8) = w;
}

__device__ void phase_prep(const Params& p, unsigned char* smem) {
    const int tid = tid_opaque(), lane = tid & 63, wave = tid >> 6, G = gridDim.x, bid = blockIdx.x;
    unsigned char* ws = p.ws;
    {
        float* sc = (float*)smem;
        float* red = sc + 10240;
        bool have = false;
        for (int task = bid; task < 192; task += G) {
            if (!have) { for (int i = tid; i < 10240; i += 512) { const float c = i < 8192 ? p.in[2][i] : p.in[3][i - 8192]; sc[i] = c * sigm(c); } have = true; }
            __syncthreads();
            const int l = task / 96, cb = task % 96, j = cb * 64 + lane;
            const float* W = p.in[4] + (size_t)l * 1024 * 6144 + j;
            float acc[10];
#pragma unroll
            for (int s = 0; s < 10; ++s) acc[s] = 0.f;
            const int kbeg = wave * 128;
#pragma unroll 8
            for (int k = 0; k < 128; ++k) { const float w = W[(size_t)(kbeg + k) * 6144];
#pragma unroll
                for (int s = 0; s < 10; ++s) acc[s] = fmaf(sc[s * 1024 + kbeg + k], w, acc[s]); }
#pragma unroll
            for (int s = 0; s < 10; ++s) red[(wave * 10 + s) * 64 + lane] = acc[s];
            __syncthreads();
            for (int i = tid; i < 640; i += 512) { const int s = i >> 6, ln = i & 63; float v = 0.f;
#pragma unroll
                for (int w = 0; w < 8; ++w) v += red[(w * 10 + s) * 64 + ln];
                const int jj = cb * 64 + ln; v += p.in[5][l * 6144 + jj];
                const int chunk = jj >> 10, d = jj & 1023;
                if (chunk == 1) v = p.in[6][l * 1024 + d] * (1.0f + v); else if (chunk == 4) v = p.in[7][l * 1024 + d] * (1.0f + v);
                ((float*)(ws + WS_MOD))[(size_t)(l * 10 + s) * 6144 + jj] = v; }
            __syncthreads();
        }
        __syncthreads();
    }
    {
        const int gt = bid * 512 + tid, gn = G * 512;
        bf16_t* wsb = (bf16_t*)(ws + WS_WS);
        for (int i = gt; i < 6 * 128 * 128 / 2; i += gn) ((unsigned*)wsb)[i] = pk2(p.in[18][2 * i], p.in[18][2 * i + 1]);
        bf16_t* d1 = (bf16_t*)(ws + WS_DFT1);
        for (int i = gt; i < 256 * 256 / 2; i += gn) { float v[2];
#pragma unroll
            for (int e = 0; e < 2; ++e) { const int idx = 2 * i + e, m = idx >> 8, k = idx & 255, po = m >> 7, ka = m & 127, pi = k >> 7, a = k & 127;
                const float rev = (float)((ka * a) & 127) * (1.0f / 128.0f); const float c = __builtin_amdgcn_cosf(rev), s = __builtin_amdgcn_sinf(rev);
                v[e] = po == 0 ? (pi == 0 ? c : -s) : (pi == 0 ? -s : -c); }
            ((unsigned*)d1)[i] = pk2(v[0], v[1]); }
        bf16_t* d2a = (bf16_t*)(ws + WS_DFT2A);
        for (int i = gt; i < 64 * 128 / 2; i += gn) { float v[2];
#pragma unroll
            for (int e = 0; e < 2; ++e) { const int idx = 2 * i + e, kb = idx >> 7, k = idx & 127, pi = k >> 6, b = k & 63;
                const float rev = (float)((kb * b) & 63) * (1.0f / 64.0f); v[e] = pi == 0 ? __builtin_amdgcn_cosf(rev) : __builtin_amdgcn_sinf(rev); }
            ((unsigned*)d2a)[i] = pk2(v[0], v[1]); }
        bf16_t* d2b = (bf16_t*)(ws + WS_DFT2B);
        for (int i = gt; i < 128 * 256 / 2; i += gn) { float v[2];
#pragma unroll
            for (int e = 0; e < 2; ++e) { const int idx = 2 * i + e, kb = idx >> 8, k = idx & 255, pi = k >> 7, b = k & 127;
                const float rev = (float)((kb * b) & 127) * (1.0f / 128.0f); v[e] = pi == 0 ? __builtin_amdgcn_cosf(rev) : __builtin_amdgcn_sinf(rev); }
            ((unsigned*)d2b)[i] = pk2(v[0], v[1]); }
    }
    {
        float* tile = (float*)smem;
        float* trig = tile + 64 * 65;
        if (tid < 64) { const float rev = (float)tid * (1.0f / 64.0f); trig[tid] = __builtin_amdgcn_cosf(rev); trig[64 + tid] = __builtin_amdgcn_sinf(rev); }
        __syncthreads();
        for (int id = bid; id < 5824; id += G) {
            const float* src; int ld, c0, k0, n0, ldd; bf16_t* dst; bool fold = false; int fg = 0;
            if (id < 640) { const int kt = id & 15, nt = id >> 4; src = p.in[8]; ld = 2560; k0 = kt * 64; n0 = nt * 64; c0 = map_ab(n0); dst = (bf16_t*)(ws + WS_WAB_IN); ldd = 1024; }
            else if (id < 896) { const int i2 = id - 640, kt = i2 & 15, nt = i2 >> 4; src = p.in[14]; ld = 1024; k0 = kt * 64; n0 = nt * 64; c0 = n0; dst = (bf16_t*)(ws + WS_WAB_OUT); ldd = 1024; }
            else if (id < 1280) { const int i2 = id - 896, kt = i2 & 15, nt = i2 >> 4; src = p.in[15]; ld = 1792; k0 = kt * 64; n0 = nt * 64; c0 = n0; dst = (bf16_t*)(ws + WS_WCD_IN); ldd = 1024; }
            else if (id < 1344) { const int i2 = id - 1280, kt = i2 & 15; fg = i2 >> 4; src = p.in[15]; ld = 1792; k0 = kt * 64; n0 = 0; c0 = 1536 + 64 * fg; dst = (bf16_t*)(ws + WS_WCD_IN); ldd = 1024; fold = true; }
            else if (id < 1600) { const int i2 = id - 1344, kt = i2 & 15, nt = i2 >> 4; src = p.in[20]; ld = 1024; k0 = kt * 64; n0 = nt * 64; c0 = n0; dst = (bf16_t*)(ws + WS_WCD_OUT); ldd = 1024; }
            else if (id < 4416) { const int i2 = id - 1600, l = i2 / 1408, i3 = i2 % 1408, kt = i3 & 15, nt = i3 >> 4; src = p.in[21] + (size_t)l * 1024 * 5632; ld = 5632; k0 = kt * 64; n0 = nt * 64; c0 = map_ffn(n0);
                dst = (bf16_t*)(ws + WS_WFFN_IN) + (size_t)l * 5632 * 1024; ldd = 1024; }
            else { const int i2 = id - 4416, l = i2 / 704, i3 = i2 % 704, kt = i3 % 44, nt = i3 / 44; src = p.in[22] + (size_t)l * 2816 * 1024; ld = 1024; k0 = kt * 64; n0 = nt * 64; c0 = n0;
                dst = (bf16_t*)(ws + WS_WFFN_OUT) + (size_t)l * 1024 * 2816; ldd = 2816; }
            tile_load(src, ld, c0, k0, tile);
            __syncthreads();
            if (!fold) tile_store_t(tile, dst, ldd, n0, k0);
            else {
                const int np = tid >> 2, part = np >> 6, k2 = np & 63, kq = tid & 3;
                const float* tr = trig + part * 64;
                float a[16];
#pragma unroll
                for (int i = 0; i < 16; ++i) a[i] = 0.f;
                for (int n2 = 0; n2 < 64; ++n2) { const float t = tr[(k2 * n2) & 63];
#pragma unroll
                    for (int i = 0; i < 16; ++i) a[i] = fmaf(tile[(kq * 16 + i) * 65 + n2], t, a[i]); }
                bf16_t* dp = dst + (size_t)(1536 + part * 256 + fg * 64 + k2) * 1024 + k0 + kq * 16;
                u32x4 w0, w1;
                w0.x = pk2(a[0], a[1]); w0.y = pk2(a[2], a[3]); w0.z = pk2(a[4], a[5]); w0.w = pk2(a[6], a[7]);
                w1.x = pk2(a[8], a[9]); w1.y = pk2(a[10], a[11]); w1.z = pk2(a[12], a[13]); w1.w = pk2(a[14], a[15]);
                *(u32x4*)dp = w0; *(u32x4*)(dp + 8) = w1;
            }
            __syncthreads();
        }
    }
}

__device__ void phase_norm(const float* src0, const float* src1, const float* modl, int chA, int chB, bf16_t* H) {
    const int tid = tid_opaque(), lane = tid & 63, wave = tid >> 6;
    const int nw = gridDim.x * 8;
    for (int row = blockIdx.x * 8 + wave; row < T_TOK; row += 2 * nw) {
        f32x4 v[2][4]; float ss[2];
#pragma unroll
        for (int r = 0; r < 2; ++r) { const int rr = (row + r * nw < T_TOK) ? row + r * nw : row;
            const float* xp = rr < T_P ? src0 + (size_t)rr * 1024 : src1 + (size_t)(rr - T_P) * 1024;
#pragma unroll
            for (int i = 0; i < 2; ++i) { v[r][2 * i] = *(const f32x4*)(xp + i * 512 + lane * 8); v[r][2 * i + 1] = *(const f32x4*)(xp + i * 512 + lane * 8 + 4); } }
#pragma unroll
        for (int r = 0; r < 2; ++r) { float s = 0.f;
#pragma unroll
            for (int i = 0; i < 4; ++i) s += v[r][i][0] * v[r][i][0] + v[r][i][1] * v[r][i][1] + v[r][i][2] * v[r][i][2] + v[r][i][3] * v[r][i][3];
            ss[r] = wave_sum(s); }
#pragma unroll
        for (int r = 0; r < 2; ++r) { const int rr = row + r * nw; if (rr >= T_TOK) break;
            const float rstd = __builtin_amdgcn_rsqf(ss[r] * (1.0f / 1024.0f) + EPSV);
            const float* mp = modl + (size_t)seq_of(rr) * 6144;
#pragma unroll
            for (int i = 0; i < 2; ++i) { const int c0 = i * 512 + lane * 8;
                const f32x4 A0 = *(const f32x4*)(mp + chA * 1024 + c0), A1 = *(const f32x4*)(mp + chA * 1024 + c0 + 4), B0 = *(const f32x4*)(mp + chB * 1024 + c0), B1 = *(const f32x4*)(mp + chB * 1024 + c0 + 4);
                const f32x4 h0 = v[r][2 * i] * rstd * A0 + B0, h1 = v[r][2 * i + 1] * rstd * A1 + B1;
                u32x4 w; w.x = pk2(h0[0], h0[1]); w.y = pk2(h0[2], h0[3]); w.z = pk2(h1[0], h1[1]); w.w = pk2(h1[2], h1[3]);
                *(u32x4*)(H + (size_t)rr * 1024 + c0) = w; } }
    }
}
__device__ void phase_final(float* out, const bf16_t* X, const float* rowpart, const float* g) {
    const int tid = tid_opaque(), lane = tid & 63, wave = tid >> 6;
    const int nw = gridDim.x * 8;
    f32x4 gv[4];
#pragma unroll
    for (int i = 0; i < 2; ++i) { gv[2 * i] = *(const f32x4*)(g + i * 512 + lane * 8); gv[2 * i + 1] = *(const f32x4*)(g + i * 512 + lane * 8 + 4); }
    for (int row = blockIdx.x * 8 + wave; row < T_TOK; row += 2 * nw) {
        u32x4 v[2][2]; f32x4 pp[2][4];
#pragma unroll
        for (int r = 0; r < 2; ++r) { const int rr = (row + r * nw < T_TOK) ? row + r * nw : row;
#pragma unroll
            for (int i = 0; i < 2; ++i) v[r][i] = *(const u32x4*)(X + (size_t)rr * 1024 + i * 512 + lane * 8);
#pragma unroll
            for (int i = 0; i < 4; ++i) pp[r][i] = *(const f32x4*)(rowpart + (size_t)rr * 16 + i * 4); }
#pragma unroll
        for (int r = 0; r < 2; ++r) { const int rr = row + r * nw; if (rr >= T_TOK) break;
            float ss = 0.f;
#pragma unroll
            for (int i = 0; i < 4; ++i) ss += (pp[r][i][0] + pp[r][i][1]) + (pp[r][i][2] + pp[r][i][3]);
            const float rstd = __builtin_amdgcn_rsqf(ss * (1.0f / 1024.0f) + EPSV);
            float* xp = out + (size_t)rr * 1024;
#pragma unroll
            for (int i = 0; i < 2; ++i) { const u32x4 q = v[r][i];
                const f32x4 a = (f32x4){__uint_as_float(q.x << 16), __uint_as_float(q.x & 0xffff0000u), __uint_as_float(q.y << 16), __uint_as_float(q.y & 0xffff0000u)};
                const f32x4 b = (f32x4){__uint_as_float(q.z << 16), __uint_as_float(q.z & 0xffff0000u), __uint_as_float(q.w << 16), __uint_as_float(q.w & 0xffff0000u)};
                *(f32x4*)(xp + i * 512 + lane * 8) = a * rstd * gv[2 * i]; *(f32x4*)(xp + i * 512 + lane * 8 + 4) = b * rstd * gv[2 * i + 1]; } }
    }
}
__device__ __forceinline__ void tile_store_scaled(const float* tile, bf16_t* __restrict__ dst, size_t seqstride, const float* __restrict__ avec, int n0, int k0) {
    const int tid = threadIdx.x, n = tid >> 3, k8 = (tid & 7) * 8;
    float f[8];
#pragma unroll
    for (int i = 0; i < 8; ++i) f[i] = tile[(k8 + i) * 65 + n];
#pragma unroll 2
    for (int sq = 0; sq < 10; ++sq) { const f32x4 a0 = *(const f32x4*)(avec + (size_t)sq * 6144 + k0 + k8), a1 = *(const f32x4*)(avec + (size_t)sq * 6144 + k0 + k8 + 4);
        u32x4 w; w.x = pk2(f[0] * a0[0], f[1] * a0[1]); w.y = pk2(f[2] * a0[2], f[3] * a0[3]); w.z = pk2(f[4] * a1[0], f[5] * a1[1]); w.w = pk2(f[6] * a1[2], f[7] * a1[3]);
        *(u32x4*)(dst + (size_t)sq * seqstride + (size_t)(n0 + n) * 1024 + k0 + k8) = w; }
}
__device__ void phase_wscaled(const Params& p, unsigned char* smem) {
    const int tid = tid_opaque();
    const float* mod = (const float*)(p.ws + WS_MOD);
    float* av = (float*)smem;
#pragma unroll 1
    for (int c = 0; c < 3; ++c) {
        const int N = (c == 1) ? 2048 : 5632;
        const float* avec = c == 0 ? mod + 4 * 1024 : c == 1 ? mod + 61440 + 1 * 1024 : mod + 61440 + 4 * 1024;
        const bf16_t* Bt = c == 0 ? (const bf16_t*)(p.ws + WS_WFFN_IN) : c == 1 ? (const bf16_t*)(p.ws + WS_WCD_IN) : (const bf16_t*)(p.ws + WS_WFFN_IN) + (size_t)5632 * 1024;
        bf16_t* dst = c == 0 ? (bf16_t*)(p.ws + WS_WF0) : c == 1 ? (bf16_t*)((unsigned char*)p.out + DO_WCD) : (bf16_t*)((unsigned char*)p.out + DO_WF1);
        const size_t sstr = (size_t)N * 1024;
        __syncthreads();
        for (int i = tid; i < 10240; i += 512) av[i] = avec[(size_t)(i >> 10) * 6144 + (i & 1023)];
        __syncthreads();
        const int nchunk = N * 128;
        for (int ch = blockIdx.x * 512 + tid; ch < nchunk; ch += gridDim.x * 512) {
            const int k8 = (ch & 127) * 8;
            const u32x4 wv = *(const u32x4*)(Bt + (size_t)ch * 8);
            float f[8];
#pragma unroll
            for (int e = 0; e < 4; ++e) { f[2 * e] = __uint_as_float(wv[e] << 16); f[2 * e + 1] = __uint_as_float(wv[e] & 0xffff0000u); }
#pragma unroll
            for (int sq = 0; sq < 10; ++sq) { const f32x4 a0 = *(const f32x4*)(av + sq * 1024 + k8), a1 = *(const f32x4*)(av + sq * 1024 + k8 + 4);
                u32x4 w; w.x = pk2(f[0] * a0[0], f[1] * a0[1]); w.y = pk2(f[2] * a0[2], f[3] * a0[3]); w.z = pk2(f[4] * a1[0], f[5] * a1[1]); w.w = pk2(f[6] * a1[2], f[7] * a1[3]);
                *(u32x4*)(dst + (size_t)sq * sstr + (size_t)ch * 8) = w; }
        }
    }
    __syncthreads();
}
__device__ void phase_bias(const Params& p, unsigned char* smem) {
    const int tid = tid_opaque(), lane = tid & 63, wave = tid >> 6, nw = gridDim.x * 8;
    float* sh = (float*)smem;
    const float* mod = (const float*)(p.ws + WS_MOD);
    float* biasb = (float*)(p.ws + WS_BIAS);
#pragma unroll 1
    for (int c = 0; c < 3; ++c) {
        const int N = (c == 1) ? 2048 : 5632;
        const float* shp = mod + (size_t)(c == 0 ? 0 : 1) * 61440 + (c == 1 ? 0 : 3) * 1024;
        const bf16_t* Bt = c == 0 ? (const bf16_t*)(p.ws + WS_WFFN_IN) : c == 1 ? (const bf16_t*)(p.ws + WS_WCD_IN) : (const bf16_t*)(p.ws + WS_WFFN_IN) + (size_t)5632 * 1024;
        float* bo = biasb + (c == 0 ? 0 : c == 1 ? 56320 : 56320 + 20480);
        __syncthreads();
        for (int i = tid; i < 10240; i += 512) sh[i] = shp[(size_t)(i >> 10) * 6144 + (i & 1023)];
        __syncthreads();
        for (int n = blockIdx.x * 8 + wave; n < N; n += nw) {
            const u32x4 w0 = *(const u32x4*)(Bt + (size_t)n * 1024 + lane * 16), w1 = *(const u32x4*)(Bt + (size_t)n * 1024 + lane * 16 + 8);
            float wf[16];
#pragma unroll
            for (int e = 0; e < 4; ++e) { wf[2 * e] = __uint_as_float(w0[e] << 16); wf[2 * e + 1] = __uint_as_float(w0[e] & 0xffff0000u); wf[8 + 2 * e] = __uint_as_float(w1[e] << 16); wf[8 + 2 * e + 1] = __uint_as_float(w1[e] & 0xffff0000u); }
            float my = 0.f;
#pragma unroll
            for (int sq = 0; sq < 10; ++sq) { float d = 0.f;
#pragma unroll
                for (int q = 0; q < 4; ++q) { const f32x4 b = *(const f32x4*)(sh + sq * 1024 + lane * 16 + q * 4); d += wf[q * 4] * b[0] + wf[q * 4 + 1] * b[1] + wf[q * 4 + 2] * b[2] + wf[q * 4 + 3] * b[3]; }
                d = wave_sum(d); if (lane == sq) my = d; }
            if (lane < 10) bo[(size_t)lane * N + n] = my;
        }
    }
    __syncthreads();
}

__device__ void phase_conv(const Params& p, unsigned char* smem) {
    const int tid = tid_opaque(), lane = tid & 63, wave = tid >> 6;
    const bf16_t* P0 = (const bf16_t*)(p.ws + WS_P);
    bf16_t* U = (bf16_t*)((unsigned char*)p.out + DO_U);
    bf16_t* gt = (bf16_t*)smem;
    float* zt = (float*)(smem + 94 * 1024);
    const float* wa = p.in[9];
    const float* wb = p.in[10];
    float w[31];
#pragma unroll
    for (int k = 0; k < 31; ++k) w[k] = wb[k * 512 + tid];
    const float bias = p.in[11][tid];
    float lg[8], lb[8];
#pragma unroll
    for (int i = 0; i < 8; ++i) { lg[i] = p.in[12][lane * 8 + i]; lb[i] = p.in[13][lane * 8 + i]; }
    const int ntiles = T_TOK / 64;
#define CONV_STAGE_LOAD(tile_, SG) do { const int t0_ = (tile_) * 64, seq_ = seq_of(t0_); \
        const int s0_ = seq_ < 8 ? seq_ * 8192 : T_P + (seq_ - 8) * 16384, s1_ = s0_ + (seq_ < 8 ? 8192 : 16384); \
        _Pragma("unroll") for (int j = 0; j < 12; ++j) { const int i = tid + 512 * j, r = i >> 6, ch = i & 63, tok = t0_ - 15 + r; \
            SG[j] = (u32x4){0u, 0u, 0u, 0u}; \
            if (i < 94 * 64 && tok >= s0_ && tok < s1_) SG[j] = *(const u32x4*)(P0 + (size_t)tok * 1536 + 1024 + ch * 8); } } while (0)
    u32x4 sg[12];
    if ((int)blockIdx.x < ntiles) CONV_STAGE_LOAD((int)blockIdx.x, sg);
    for (int tile = blockIdx.x; tile < ntiles; tile += gridDim.x) {
        const int t0 = tile * 64, seq = seq_of(t0);
        const int s0 = seq < 8 ? seq * 8192 : T_P + (seq - 8) * 16384, s1 = s0 + (seq < 8 ? 8192 : 16384);
#pragma unroll
        for (int j = 0; j < 12; ++j) { const int i = tid + 512 * j, r = i >> 6, ch = i & 63; if (i < 94 * 64) *(u32x4*)(gt + r * 512 + ch * 8) = sg[j]; }
        __syncthreads();
        if (tile + (int)gridDim.x < ntiles) CONV_STAGE_LOAD(tile + (int)gridDim.x, sg);
#pragma unroll 1
        for (int grp = 0; grp < 4; ++grp) {
            u32x4 yab[2], yx0[2], yxm[2], yxp[2];
#pragma unroll
            for (int j = 0; j < 2; ++j) { const int i = tid + 512 * j, t = grp * 16 + (i >> 6), ch = i & 63, tok = t0 + t, c0 = ch * 8;
                const bf16_t* rp = P0 + (size_t)tok * 1536;
                yab[j] = *(const u32x4*)(rp + c0); yx0[j] = *(const u32x4*)(rp + 512 + c0);
                yxm[j] = (u32x4){0u, 0u, 0u, 0u}; yxp[j] = (u32x4){0u, 0u, 0u, 0u};
                if (tok - 1 >= s0) yxm[j] = *(const u32x4*)(rp - 1536 + 512 + c0);
                if (tok + 1 < s1) yxp[j] = *(const u32x4*)(rp + 1536 + 512 + c0); }
            float g[46];
#pragma unroll
            for (int i = 0; i < 46; ++i) g[i] = bf2f(gt[(grp * 16 + i) * 512 + tid]);
#pragma unroll
            for (int t = 0; t < 16; ++t) { float a = bias;
#pragma unroll
                for (int k = 0; k < 31; ++k) a = fmaf(w[k], g[t + k], a);
                zt[t * 512 + tid] = a; }
            __syncthreads();
#pragma unroll
            for (int tt = 0; tt < 2; ++tt) { const int t = wave * 2 + tt;
                const f32x4 z0 = *(const f32x4*)(zt + t * 512 + lane * 8), z1 = *(const f32x4*)(zt + t * 512 + lane * 8 + 4);
                float s = (z0[0] + z0[1]) + (z0[2] + z0[3]) + (z1[0] + z1[1]) + (z1[2] + z1[3]);
                s = wave_sum(s); const float mu = s * (1.0f / 512.0f);
                const f32x4 d0 = z0 - mu, d1 = z1 - mu;
                float q = d0[0] * d0[0] + d0[1] * d0[1] + d0[2] * d0[2] + d0[3] * d0[3] + d1[0] * d1[0] + d1[1] * d1[1] + d1[2] * d1[2] + d1[3] * d1[3];
                q = wave_sum(q); const float rstd = __builtin_amdgcn_rsqf(q * (1.0f / 512.0f) + EPSV);
                float r[8];
#pragma unroll
                for (int e = 0; e < 8; ++e) { const float d = e < 4 ? d0[e & 3] : d1[e & 3]; const float y = d * rstd * lg[e] + lb[e]; r[e] = y * sigm(y); }
                u32x4 o; o.x = pk2(r[0], r[1]); o.y = pk2(r[2], r[3]); o.z = pk2(r[4], r[5]); o.w = pk2(r[6], r[7]);
                *(u32x4*)(U + (size_t)(t0 + grp * 16 + t) * 1024 + 512 + lane * 8) = o; }
#pragma unroll
            for (int j = 0; j < 2; ++j) { const int i = tid + 512 * j, t = grp * 16 + (i >> 6), ch = i & 63, tok = t0 + t, c0 = ch * 8;
                const u32x4 ab = yab[j], x0 = yx0[j], xm = yxm[j], xp = yxp[j];
                const f32x4 w0a = *(const f32x4*)(wa + c0), w0b = *(const f32x4*)(wa + c0 + 4), w1a = *(const f32x4*)(wa + 512 + c0), w1b = *(const f32x4*)(wa + 512 + c0 + 4),
                            w2a = *(const f32x4*)(wa + 1024 + c0), w2b = *(const f32x4*)(wa + 1024 + c0 + 4);
                float r[8];
#pragma unroll
                for (int e = 0; e < 8; ++e) { const unsigned sh = (e & 1) * 16; const int q = e >> 1;
                    const float fab = __uint_as_float((ab[q] >> sh) << 16), f0 = __uint_as_float((x0[q] >> sh) << 16), fm = __uint_as_float((xm[q] >> sh) << 16), fp = __uint_as_float((xp[q] >> sh) << 16);
                    const float k0 = e < 4 ? w0a[e & 3] : w0b[e & 3], k1 = e < 4 ? w1a[e & 3] : w1b[e & 3], k2 = e < 4 ? w2a[e & 3] : w2b[e & 3];
                    r[e] = fab * (k0 * fm + k1 * f0 + k2 * fp); }
                u32x4 o; o.x = pk2(r[0], r[1]); o.y = pk2(r[2], r[3]); o.z = pk2(r[4], r[5]); o.w = pk2(r[6], r[7]);
                *(u32x4*)(U + (size_t)tok * 1024 + c0) = o; }
            __syncthreads();
        }
    }
#undef CONV_STAGE_LOAD
}

__device__ void phase_sg(const Params& p, unsigned char* smem) {
    const int tid = tid_opaque(), lane = tid & 63, wave = tid >> 6, fr = lane & 15, fq = lane >> 4;
    const bf16_t* P1 = (const bf16_t*)(p.ws + WS_P);
    bf16_t* U = (bf16_t*)((unsigned char*)p.out + DO_U);
    const bf16_t* Wsb = (const bf16_t*)(p.ws + WS_WS);
    float* st = (float*)smem;
    bf16_t* vnT = (bf16_t*)(smem + 1024);
    constexpr int PITCH = 136;
    const int pp = wave * 16 + fr;
#define SG_LOAD(h_, WF, UU, BS, VA) do { \
        _Pragma("unroll") for (int kk = 0; kk < 4; ++kk) WF[kk] = *(const bf16x8*)(Wsb + (size_t)((h_) * 128 + pp) * 128 + kk * 32 + fq * 8); \
        _Pragma("unroll") for (int mt = 0; mt < 8; ++mt) UU[mt] = *(const u32x2*)(P1 + (size_t)(t0 + pp) * 2048 + (h_) * 128 + mt * 16 + 4 * fq); \
        BS = p.in[19][(h_) * 128 + pp]; \
        _Pragma("unroll") for (int j = 0; j < 4; ++j) { const int item = tid + 512 * j, q = item & 127, dc = item >> 7; VA[j] = *(const u32x4*)(P1 + (size_t)(t0 + q) * 2048 + 768 + (h_) * 128 + dc * 8); } \
    } while (0)
    for (int chunk = blockIdx.x; chunk < T_TOK / 128; chunk += gridDim.x) {
        const int t0 = chunk * 128;
        bf16x8 wfN[4]; u32x2 uuN[8]; float bsN; u32x4 vaN[4];
        SG_LOAD(0, wfN, uuN, bsN, vaN);
#pragma unroll 1
        for (int half = 0; half < 2; ++half) {
            u32x4 av[8], bv[8];
#pragma unroll
            for (int tt = 0; tt < 8; ++tt) { const int q = wave * 16 + half * 8 + tt; const bf16_t* vp = P1 + (size_t)(t0 + q) * 2048 + 768;
                av[tt] = *(const u32x4*)(vp + lane * 8); bv[tt] = (u32x4){0u, 0u, 0u, 0u}; if (lane < 32) bv[tt] = *(const u32x4*)(vp + 512 + lane * 8); }
#pragma unroll
            for (int tt = 0; tt < 8; ++tt) { const int q = wave * 16 + half * 8 + tt; const u32x4 a = av[tt], b = bv[tt];
                float s = 0.f, ss = 0.f;
#pragma unroll
                for (int e = 0; e < 4; ++e) { const float x0 = __uint_as_float(a[e] << 16), x1 = __uint_as_float(a[e] & 0xffff0000u), y0 = __uint_as_float(b[e] << 16), y1 = __uint_as_float(b[e] & 0xffff0000u);
                    s += (x0 + x1) + (y0 + y1); ss += (x0 * x0 + x1 * x1) + (y0 * y0 + y1 * y1); }
                s = wave_sum(s); ss = wave_sum(ss);
                const float mu = s * (1.0f / 768.0f); const float var = ss * (1.0f / 768.0f) - mu * mu;
                if (lane == 0) { st[q * 2] = mu; st[q * 2 + 1] = __builtin_amdgcn_rsqf(fmaxf(var, 0.f) + EPSV); } }
        }
        __syncthreads();
#pragma unroll
        for (int h = 0; h < 6; ++h) {
            bf16x8 wf[4]; u32x2 uu[8]; u32x4 va[4]; const float bsv = bsN;
#pragma unroll
            for (int i = 0; i < 4; ++i) { wf[i] = wfN[i]; va[i] = vaN[i]; }
#pragma unroll
            for (int i = 0; i < 8; ++i) uu[i] = uuN[i];
#pragma unroll
            for (int j = 0; j < 4; ++j) { const int item = tid + 512 * j, q = item & 127, dc = item >> 7;
                const u32x4 a = va[j];
                const float mu = st[q * 2], rs = st[q * 2 + 1];
                const float* lg = p.in[16] + h * 128 + dc * 8; const float* lb = p.in[17] + h * 128 + dc * 8;
#pragma unroll
                for (int e = 0; e < 8; ++e) { const float x = (e & 1) ? __uint_as_float(a[e >> 1] & 0xffff0000u) : __uint_as_float(a[e >> 1] << 16);
                    const float y = (x - mu) * rs * lg[e] + lb[e];
                    vnT[(dc * 8 + e) * PITCH + q] = (bf16_t)(pk2(y, 0.f) & 0xffffu); } }
            __syncthreads();
            if (h < 5) SG_LOAD(h + 1, wfN, uuN, bsN, vaN);
            const size_t tokoff = (size_t)(t0 + pp);
#pragma unroll
            for (int mt = 0; mt < 8; ++mt) { f32x4 acc = (f32x4){0.f, 0.f, 0.f, 0.f};
#pragma unroll
                for (int kk = 0; kk < 4; ++kk) { const bf16x8 af = *(const bf16x8*)(vnT + (mt * 16 + fr) * PITCH + kk * 32 + fq * 8);
                    acc = __builtin_amdgcn_mfma_f32_16x16x32_bf16(af, wf[kk], acc, 0, 0, 0); }
                const int col = h * 128 + mt * 16 + 4 * fq;
                const u32x2 u2 = uu[mt];
                const float u0 = __uint_as_float(u2.x << 16), u1 = __uint_as_float(u2.x & 0xffff0000u), u2f = __uint_as_float(u2.y << 16), u3 = __uint_as_float(u2.y & 0xffff0000u);
                u32x2 o; o.x = pk2(u0 * (acc[0] + bsv), u1 * (acc[1] + bsv)); o.y = pk2(u2f * (acc[2] + bsv), u3 * (acc[3] + bsv));
                *(u32x2*)(U + tokoff * 1024 + col) = o; }
            __syncthreads();
        }
    }
#undef SG_LOAD
}

__device__ void phase_fft1(const Params& p, unsigned char* smem) {
    const int tid = tid_opaque(), lane = tid & 63, wave = tid >> 6, fr = lane & 15, fq = lane >> 4;
    const bf16_t* P1 = (const bf16_t*)(p.ws + WS_P);
    bf16_t* Y1 = (bf16_t*)(p.ws + WS_Y1);
    const bf16_t* D1 = (const bf16_t*)(p.ws + WS_DFT1);
    bf16_t* BT = (bf16_t*)smem;
    constexpr int PITCH = 264;
    bf16x8 af[2][8];
#pragma unroll
    for (int i = 0; i < 2; ++i)
#pragma unroll
        for (int kk = 0; kk < 8; ++kk) af[i][kk] = *(const bf16x8*)(D1 + (size_t)(i * 128 + wave * 16 + fr) * 256 + kk * 32 + fq * 8);
#define F1_DECODE(u_, seq_, b_, cblk_, N2_, tokbase_) do { int rem_; \
        if ((u_) < 2048) { seq_ = (u_) >> 8; rem_ = (u_) & 255; N2_ = 64; tokbase_ = seq_ * 8192; } else { const int u2_ = (u_) - 2048; seq_ = 8 + (u2_ >> 9); rem_ = u2_ & 511; N2_ = 128; tokbase_ = T_P + (seq_ - 8) * 16384; } \
        b_ = rem_ >> 2; cblk_ = rem_ & 3; } while (0)
#define F1_LOAD(u_, V) do { int seq_, b_, cblk_, N2_, tb_; F1_DECODE(u_, seq_, b_, cblk_, N2_, tb_); \
        _Pragma("unroll") for (int j = 0; j < 4; ++j) { const int item = tid + 512 * j, a = item & 127, rest = item >> 7, part = rest >> 3, ch8 = rest & 7; \
            V[j] = *(const u32x4*)(P1 + (size_t)(tb_ + a * N2_ + b_) * 2048 + 1536 + part * 256 + cblk_ * 64 + ch8 * 8); } } while (0)
    u32x4 nx[4];
    if ((int)blockIdx.x < 3072) F1_LOAD((int)blockIdx.x, nx);
    for (int u = blockIdx.x; u < 3072; u += gridDim.x) {
        int seq, b, cblk, N2, tokbase; F1_DECODE(u, seq, b, cblk, N2, tokbase);
#pragma unroll
        for (int j = 0; j < 4; ++j) { const int item = tid + 512 * j, a = item & 127, rest = item >> 7, part = rest >> 3, ch8 = rest & 7;
            const u32x4 v = nx[j];
#pragma unroll
            for (int e = 0; e < 8; ++e) BT[(ch8 * 8 + e) * PITCH + part * 128 + a] = (bf16_t)((e & 1) ? (v[e >> 1] >> 16) : (v[e >> 1] & 0xffffu)); }
        __syncthreads();
        if (u + (int)gridDim.x < 3072) F1_LOAD(u + (int)gridDim.x, nx);
        f32x4 acc[2][4];
#pragma unroll
        for (int i = 0; i < 2; ++i)
#pragma unroll
            for (int nt = 0; nt < 4; ++nt) acc[i][nt] = (f32x4){0.f, 0.f, 0.f, 0.f};
#pragma unroll
        for (int kk = 0; kk < 8; ++kk)
#pragma unroll
            for (int nt = 0; nt < 4; ++nt) { const bf16x8 bfr = *(const bf16x8*)(BT + (nt * 16 + fr) * PITCH + kk * 32 + fq * 8);
                acc[0][nt] = __builtin_amdgcn_mfma_f32_16x16x32_bf16(bfr, af[0][kk], acc[0][nt], 0, 0, 0);
                acc[1][nt] = __builtin_amdgcn_mfma_f32_16x16x32_bf16(bfr, af[1][kk], acc[1][nt], 0, 0, 0); }
        const int ka = wave * 16 + fr, S = N2 * 128;
        const float rev = (float)((ka * b) & (S - 1)) / (float)S; const float cw = __builtin_amdgcn_cosf(rev), sw = __builtin_amdgcn_sinf(rev);
        bf16_t* yp = Y1 + (size_t)(tokbase + ka * N2 + b) * 512 + cblk * 64 + 4 * fq;
#pragma unroll
        for (int nt = 0; nt < 4; ++nt) { const f32x4 yr = acc[0][nt], yi = acc[1][nt];
            const f32x4 zr = yr * cw + yi * sw, zi = yi * cw - yr * sw;
            u32x2 o; o.x = pk2(zr[0], zr[1]); o.y = pk2(zr[2], zr[3]); *(u32x2*)(yp + nt * 16) = o;
            o.x = pk2(zi[0], zi[1]); o.y = pk2(zi[2], zi[3]); *(u32x2*)(yp + 256 + nt * 16) = o; }
        __syncthreads();
    }
#undef F1_LOAD
#undef F1_DECODE
}
__device__ void phase_fft2(const Params& p, unsigned char* smem) {
    const int tid = tid_opaque(), lane = tid & 63, wave = tid >> 6, fr = lane & 15, fq = lane >> 4;
    const bf16_t* Y1 = (const bf16_t*)(p.ws + WS_Y1);
    bf16_t* U = (bf16_t*)((unsigned char*)p.out + DO_U);
    bf16_t* BT = (bf16_t*)smem;
    constexpr int PITCH = 264;
#define F2_DECODE(u_, N2_, lg2_, tokbase_, ka_, cblk_) do { \
        if ((u_) < 4096) { N2_ = 64; lg2_ = 6; tokbase_ = ((u_) >> 9) * 8192; } else { N2_ = 128; lg2_ = 7; tokbase_ = T_P + (((u_) - 4096) >> 9) * 16384; } \
        const int rem_ = (u_) & 511; ka_ = rem_ >> 2; cblk_ = rem_ & 3; } while (0)
#define F2_LOAD(u_, V) do { int N2_, lg2_, tb_, ka_, cblk_; F2_DECODE(u_, N2_, lg2_, tb_, ka_, cblk_); \
        _Pragma("unroll") for (int j = 0; j < 4; ++j) { const int item = tid + 512 * j; if (item < N2_ * 16) { const int b = item & (N2_ - 1), rest = item >> lg2_, part = rest >> 3, ch8 = rest & 7; \
            V[j] = *(const u32x4*)(Y1 + (size_t)(tb_ + ka_ * N2_ + b) * 512 + part * 256 + cblk_ * 64 + ch8 * 8); } } } while (0)
    u32x4 nx[4];
#pragma unroll
    for (int j = 0; j < 4; ++j) nx[j] = (u32x4){0u, 0u, 0u, 0u};
    if ((int)blockIdx.x < 5120) F2_LOAD((int)blockIdx.x, nx);
    for (int u = blockIdx.x; u < 5120; u += gridDim.x) {
        int N2, lg2, tokbase, ka, cblk; F2_DECODE(u, N2, lg2, tokbase, ka, cblk);
        const bf16_t* D2 = (N2 == 128) ? (const bf16_t*)(p.ws + WS_DFT2B) : (const bf16_t*)(p.ws + WS_DFT2A);
#pragma unroll
        for (int j = 0; j < 4; ++j) { const int item = tid + 512 * j; if (item < N2 * 16) { const int b = item & (N2 - 1), rest = item >> lg2, part = rest >> 3, ch8 = rest & 7;
            const u32x4 v = nx[j];
#pragma unroll
            for (int e = 0; e < 8; ++e) BT[(ch8 * 8 + e) * PITCH + part * N2 + b] = (bf16_t)((e & 1) ? (v[e >> 1] >> 16) : (v[e >> 1] & 0xffffu)); } }
        __syncthreads();
        if (u + (int)gridDim.x < 5120) F2_LOAD(u + (int)gridDim.x, nx);
        const int nb = (N2 == 128) ? wave : (wave & 3), mt0 = (N2 == 128) ? 0 : 2 * (wave >> 2), nmt = (N2 == 128) ? 4 : 2, ksteps = N2 >> 4, K2 = 2 * N2;
        f32x4 acc[4];
#pragma unroll
        for (int i = 0; i < 4; ++i) acc[i] = (f32x4){0.f, 0.f, 0.f, 0.f};
        for (int kk = 0; kk < ksteps; ++kk) { const bf16x8 df = *(const bf16x8*)(D2 + (size_t)(nb * 16 + fr) * K2 + kk * 32 + fq * 8);
#pragma unroll
            for (int i = 0; i < 4; ++i) if (i < nmt) { const bf16x8 bfr = *(const bf16x8*)(BT + ((mt0 + i) * 16 + fr) * PITCH + kk * 32 + fq * 8);
                acc[i] = __builtin_amdgcn_mfma_f32_16x16x32_bf16(bfr, df, acc[i], 0, 0, 0); } }
        const float scale = (N2 == 128) ? 9.765625e-4f : 1.3810679e-3f;
        const int kb = nb * 16 + fr;
        bf16_t* up = U + (size_t)(tokbase + ka + 128 * kb) * 1024 + 768 + cblk * 64 + 4 * fq;
#pragma unroll
        for (int i = 0; i < 4; ++i) if (i < nmt) { const f32x4 y = acc[i] * scale; u32x2 o; o.x = pk2(y[0], y[1]); o.y = pk2(y[2], y[3]); *(u32x2*)(up + (mt0 + i) * 16) = o; }
        __syncthreads();
    }
#undef F2_LOAD
#undef F2_DECODE
}

#define XB_TMO      128
#define XB_XCNT(j)  (256  + 64 * (j))
#define XB_XSUB(j)  (1280 + 64 * (j))
#define XB_XGEN(j)  (2304 + 64 * (j))
#define XB_TOP      3328
#define XB_TOPGEN   3392
#define XCD_BAR_WORDS 3456
#define XB_SPIN_CAP (1u << 22)
__device__ __forceinline__ unsigned xb_ld(unsigned* p)              { return __hip_atomic_load(p, __ATOMIC_RELAXED, __HIP_MEMORY_SCOPE_AGENT); }
__device__ __forceinline__ unsigned xb_add(unsigned* p, unsigned v) { return __hip_atomic_fetch_add(p, v, __ATOMIC_RELAXED, __HIP_MEMORY_SCOPE_AGENT); }
__device__ __forceinline__ unsigned xb_xcc_id() { return (unsigned)__builtin_amdgcn_s_getreg((3 << 11) | 20) & 0xFu; }
#define XB_SPIN(cond, bar) do { unsigned _sp = 0; while (cond) { __builtin_amdgcn_s_sleep(1); \
    if ((++_sp & 255u) == 0u) { if (xb_ld(&(bar)[XB_TMO])) break; if (_sp > XB_SPIN_CAP) { atomicAdd(&(bar)[XB_TMO], 1u); break; } } } } while (0)
struct XcdBarrier { unsigned* bar; unsigned x; volatile LAS unsigned* st; };
__device__ __forceinline__ XcdBarrier xcd_barrier_post(unsigned* bar, volatile LAS unsigned* st) {
    XcdBarrier b; b.bar = bar; b.x = xb_xcc_id(); b.st = st;
    if (threadIdx.x == 0) (void)xb_add(&bar[XB_XCNT(b.x)], 1u);
    return b;
}
__device__ __forceinline__ void xcd_barrier_complete(unsigned* bar, unsigned x, unsigned& nloc, unsigned& nx) {
    const unsigned G = gridDim.x * gridDim.y * gridDim.z;
    unsigned sum, cnt, mine, sp = 0u;
    for (;;) {
        sum = 0u; cnt = 0u; mine = 0u;
#pragma unroll
        for (unsigned j = 0; j < 16; ++j) { const unsigned c = xb_ld(&bar[XB_XCNT(j)]); sum += c; cnt += (c > 0u) ? 1u : 0u; mine = (j == x) ? c : mine; }
        if (sum == G) break;
        __builtin_amdgcn_s_sleep(1);
        if ((++sp & 255u) == 0u) { if (xb_ld(&bar[XB_TMO])) break; if (sp > XB_SPIN_CAP) { atomicAdd(&bar[XB_TMO], 1u); break; } }
    }
    nloc = mine > 0u ? mine : 1u; nx = cnt > 0u ? cnt : 1u;
}
__device__ __forceinline__ void xcd_barrier(const XcdBarrier& b) {
    asm volatile("s_waitcnt vmcnt(0)" ::: "memory");
    __syncthreads();
    if (threadIdx.x == 0) {
        unsigned* bar = b.bar;
        __builtin_amdgcn_s_waitcnt(0);
        unsigned nloc = b.st[0], nx = b.st[1];
        if (nloc == 0u) { xcd_barrier_complete(bar, b.x, nloc, nx); b.st[0] = nloc; b.st[1] = nx; }
        const unsigned old = xb_add(&bar[XB_XSUB(b.x)], 1u);
        const unsigned gen = old / nloc;
        if (old + 1u == (gen + 1u) * nloc) {
            __builtin_amdgcn_fence(__ATOMIC_RELEASE, "agent");
            asm volatile("s_waitcnt vmcnt(0)" ::: "memory");
            const unsigned og = xb_add(&bar[XB_TOP], 1u);
            const unsigned tg = og / nx;
            if (og + 1u == (tg + 1u) * nx) xb_add(&bar[XB_TOPGEN], 1u);
            else XB_SPIN(xb_ld(&bar[XB_TOPGEN]) == tg, bar);
            __builtin_amdgcn_fence(__ATOMIC_ACQUIRE, "agent");
            xb_add(&bar[XB_XGEN(b.x)], 1u);
            asm volatile("s_waitcnt vmcnt(0)" ::: "memory");
        } else {
            XB_SPIN(xb_ld(&bar[XB_XGEN(b.x)]) == gen, bar);
            __builtin_amdgcn_fence(__ATOMIC_ACQUIRE, "agent");
            asm volatile("s_waitcnt vmcnt(0)" ::: "memory");
        }
    }
    __syncthreads();
}

__device__ __forceinline__ int opaque(int v) { int r; asm volatile("s_mov_b32 %0, %1" : "=s"(r) : "s"(v)); return r; }
__global__ void __launch_bounds__(512, 2) fwd_mega(Params p) {
    extern __shared__ __attribute__((aligned(16))) unsigned char smem[];
    cg::grid_group grid = cg::this_grid();
    LAS unsigned char* lds = (LAS unsigned char*)smem;
    unsigned char* ws = p.ws;
    const int lo = p.ph_lo, hi = p.ph_hi, G = gridDim.x, bid = blockIdx.x;
    const float* mod = (const float*)(ws + WS_MOD);
    bf16_t* H = (bf16_t*)(ws + WS_H);
    bf16_t* P = (bf16_t*)(ws + WS_P);
    float* out = p.out;
    bf16_t* U = (bf16_t*)((unsigned char*)p.out + DO_U);
    bf16_t* X = H;
    float* rowpart = (float*)(ws + WS_RP);
    const float* biasb = (const float*)(ws + WS_BIAS);
    bool first = true;
    volatile LAS unsigned* xst = (volatile LAS unsigned*)(lds + 131072);
    if (threadIdx.x == 0) { xst[0] = 0u; xst[1] = 0u; }
    __syncthreads();
    XcdBarrier xbar = xcd_barrier_post((unsigned*)(ws + WS_BAR), xst);
    int nseam = 0;
#if PROBE_SYNCS
    for (int i = 0; i < PROBE_SYNCS; ++i) grid.sync();
#endif
#pragma unroll 1
    for (int ph = lo; ph < hi; ++ph) {
        if (ph == 5 || ph == 8 || ph == 13) continue;
#if PROBE_MASK
        for (int rep = 0; rep < (((PROBE_MASK >> ph) & 1) ? 2 : 1); ++rep) {
#endif
        if (!first) { if (nseam == 0) grid.sync(); else xcd_barrier(xbar); ++nseam; }
        first = false;
        const int l = ph >= 8 ? 1 : 0;
        const float* modl = mod + (size_t)l * 61440;
        if (ph == 0) phase_prep(p, smem);
        else if (ph == 1) { phase_wscaled(p, smem); phase_bias(p, smem); phase_norm(p.in[0], p.in[1], mod, 1, 0, H); }
        else if (ph == 2) { pg8::Gemm g{H, (const bf16_t*)(ws + WS_WAB_IN), T_TOK, opaque(2560), opaque(1024), 0}; pg8::StaticOrder S; S.init(T_TOK, g.N, G, bid);
            EpiAct<0> E{P, 1536, nullptr, nullptr, 0}; pg8::gemm_phase<EpiAct<0>, pg8::StaticOrder>(lds, g, S, E); }
#if PROBE_HOT
        else if (ph == 3) { { struct HotOrder : pg8::StaticOrder { __device__ bool next(int i, Unit& u) const { if (!pg8::StaticOrder::next(i, u)) return false; u.pm = 0; u.pn = u.pn % PROBE_HOT; return true; } };
            pg8::Gemm g{H, (const bf16_t*)(ws + WS_WAB_IN), T_TOK, opaque(2560), opaque(1024), 0}; HotOrder S; S.init(T_TOK, g.N, G, bid);
            EpiAct<2> E{(bf16_t*)(ws + WS_END), 2560, nullptr, nullptr, 0}; pg8::gemm_phase<EpiAct<2>, HotOrder>(lds, g, S, E); }
            grid.sync(); phase_conv(p, smem); }
#else
        else if (ph == 3) phase_conv(p, smem);
#endif
        else if (ph == 4) { pg8::Gemm g{U, (const bf16_t*)(ws + WS_WAB_OUT), T_TOK, opaque(1024), opaque(1024), 0}; pg8::StaticOrder S; S.init(T_TOK, g.N, G, bid);
            EpiRes<true> E{p.in[0], p.in[1], X, mod + 2 * 1024, rowpart}; pg8::gemm_phase<EpiRes<true>, pg8::StaticOrder>(lds, g, S, E); }
        else if (ph == 7 || ph == 12 || ph == 15) {
            const bool ffn = (ph != 12);
            const bf16_t* A = ffn ? P : U;
            const bf16_t* Bt = ph == 12 ? (const bf16_t*)(ws + WS_WCD_OUT) : (const bf16_t*)(ws + WS_WFFN_OUT) + (size_t)l * 1024 * 2816;
            pg8::Gemm g{A, Bt, T_TOK, opaque(1024), opaque(ffn ? DFF : 1024), 0}; pg8::StaticOrder S; S.init(T_TOK, g.N, G, bid);
            const int ri = ph == 7 ? 1 : ph == 12 ? 2 : 3;
            EpiRes<false> E{nullptr, nullptr, X, modl + (ffn ? 5 : 2) * 1024, rowpart + (size_t)ri * T_TOK * 16};
            pg8::gemm_phase<EpiRes<false>, pg8::StaticOrder>(lds, g, S, E);
        }
        else if (ph == 6 || ph == 14) { const bf16_t* Bt = l == 0 ? (const bf16_t*)(ws + WS_WF0) : (const bf16_t*)((unsigned char*)p.out + DO_WF1);
            pg8::Gemm g{X, Bt, T_TOK, opaque(5632), opaque(1024), (size_t)5632 * 1024 * 2}; pg8::StaticOrder S; S.init(T_TOK, g.N, G, bid);
            EpiAct<1> E{P, DFF, rowpart + (size_t)(l == 0 ? 0 : 2) * T_TOK * 16, biasb + (l == 0 ? 0 : 56320 + 20480), 5632}; pg8::gemm_phase<EpiAct<1>, pg8::StaticOrder>(lds, g, S, E); }
        else if (ph == 9) { pg8::Gemm g{X, (const bf16_t*)((unsigned char*)p.out + DO_WCD), T_TOK, opaque(2048), opaque(1024), (size_t)2048 * 1024 * 2}; pg8::StaticOrder S; S.init(T_TOK, g.N, G, bid);
            EpiAct<2> E{P, 2048, rowpart + (size_t)1 * T_TOK * 16, biasb + 56320, 2048}; pg8::gemm_phase<EpiAct<2>, pg8::StaticOrder>(lds, g, S, E); }
#if PROBE_SG
        else if (ph == 10) { phase_sg(p, smem); __syncthreads(); phase_sg(p, smem); __syncthreads(); phase_fft1(p, smem); }
#else
        else if (ph == 10) { phase_sg(p, smem); __syncthreads(); phase_fft1(p, smem); }
#endif
        else if (ph == 11) phase_fft2(p, smem);
        else if (ph == 16) phase_final(out, X, rowpart + (size_t)3 * T_TOK * 16, p.in[23]);
#if PROBE_MASK
        }
#endif
    }
}

#ifndef N_LAUNCH_SPLIT
#define N_LAUNCH_SPLIT 0
#endif
extern "C" void kernel_launch(void* const* d_in, const int* in_sizes, int n_in, void* d_out, int out_size, void* d_ws, size_t ws_size, hipStream_t stream) {
    static int grid = 0;
    if (grid == 0) {
        if (n_in != 24 || ws_size < WS_END) { fprintf(stderr, "kernel_launch: unexpected n_in %d or ws_size %zu (need %zu)\n", n_in, ws_size, (size_t)WS_END); grid = -1; return; }
        int dev = 0, cus = 0, per_cu = 0;
        hipGetDevice(&dev);
        hipDeviceGetAttribute(&cus, hipDeviceAttributeMultiprocessorCount, dev);
        if (hipFuncSetAttribute((const void*)fwd_mega, hipFuncAttributeMaxDynamicSharedMemorySize, LDS_BYTES) != hipSuccess) { fprintf(stderr, "kernel_launch: hipFuncSetAttribute failed\n"); grid = -1; return; }
        if (hipOccupancyMaxActiveBlocksPerMultiprocessor(&per_cu, (const void*)fwd_mega, 512, LDS_BYTES) != hipSuccess || per_cu < 1) { fprintf(stderr, "kernel_launch: occupancy query says %d\n", per_cu); per_cu = 1; }
        (void)hipGetLastError();
        grid = cus;
        if (grid > 256) grid = 256;
    }
    if (grid < 0) return;
    Params p{};
    for (int i = 0; i < 24; ++i) p.in[i] = (const float*)d_in[i];
    p.out = (float*)d_out; p.ws = (unsigned char*)d_ws;
#if N_LAUNCH_SPLIT
    for (int ph = 0; ph < 17; ++ph) { p.ph_lo = ph; p.ph_hi = ph + 1; void* args[] = {&p};
        hipError_t e = hipLaunchCooperativeKernel((const void*)fwd_mega, dim3(grid), dim3(512), args, LDS_BYTES, stream);
        if (e != hipSuccess) { fprintf(stderr, "cooperative launch failed: %s (grid %d)\n", hipGetErrorString(e), grid); break; } }
#else
    if (hipMemsetAsync((char*)d_ws + WS_BAR, 0, 16384, stream) != hipSuccess) { fprintf(stderr, "kernel_launch: memset of barrier words failed\n"); return; }
    p.ph_lo = 0; p.ph_hi = 17; void* args[] = {&p};
    hipError_t e = hipLaunchCooperativeKernel((const void*)fwd_mega, dim3(grid), dim3(512), args, LDS_BYTES, stream);
    if (e != hipSuccess) fprintf(stderr, "cooperative launch failed: %s (grid %d)\n", hipGetErrorString(e), grid);
#endif
}
```

```cpp
#include <hip/hip_runtime.h>
#include <hip/hip_cooperative_groups.h>
#include <cstdio>
namespace cg = cooperative_groups;

namespace pg8 {
#define PG8_LAS __attribute__((address_space(3)))
typedef unsigned short bf16_t;
typedef short bf16x8 __attribute__((ext_vector_type(8)));
typedef float f32x4 __attribute__((ext_vector_type(4)));
typedef unsigned u32x4 __attribute__((ext_vector_type(4)));
constexpr int BM = 256, BK = 64, HALF = 128, HTB = HALF * BK * 2  , STAGE_BYTES = 8 * HTB, NXCD = 8, WGM = 8;

__host__ __device__ __forceinline__ int lds_byte(int r, int c) { const int st = (r >> 4) * 2 + (c >> 5), rr = r & 15, cc = c & 31, ob = rr * 64 + cc * 2; return st * 1024 + (ob ^ (((ob >> 9) & 1) << 5)); }
__host__ __device__ __forceinline__ void stage_rc(int b, int& R, int& C) { const int st = b / 1024, sb = b % 1024, swz = sb ^ (((sb >> 9) & 1) << 5); R = (st >> 1) * 16 + swz / 64; C = (st & 1) * 32 + (swz % 64) / 2; }
__host__ __device__ __forceinline__ int perm32(int rho) { const int n = rho >> 4, i = rho & 15; return 8 * (i >> 2) + 4 * n + (i & 3); }

struct Unit { int pm, pn; };
struct Gemm { const bf16_t* A; const bf16_t* Bt; int M, N, K; size_t bseq; };
__device__ __forceinline__ int seq_of_pm(int pm) { return pm < 256 ? (pm >> 5) : 8 + ((pm - 256) >> 6); }

struct StaticOrder {
    int nM, nN, nwg, G, c;
    __host__ __device__ void init(int M, int N, int G_, int c_) { nM = M / BM; nN = N / BM; nwg = nM * nN; G = G_; c = c_; }
    __host__ __device__ bool next(int i, Unit& u) const {
        const long L = (long)i * G + c; if (L >= nwg) return false;
        int wgid = (int)L; { const int q = nwg / NXCD, r = nwg % NXCD, xcd = wgid % NXCD, off = wgid / NXCD; wgid = (xcd < r ? xcd * (q + 1) : r * (q + 1) + (xcd - r) * q) + off; }
        const int nig = WGM * nN, gid = wgid / nig, fm = gid * WGM, gsz = (nM - fm) < WGM ? (nM - fm) : WGM;
        u.pm = fm + ((wgid % nig) % gsz); u.pn = (wgid % nig) / gsz; return true;
    }
    __device__ __forceinline__ void a_ready(const Unit&) const {}
    __device__ __forceinline__ void done(const Unit&) const {}
};
__device__ __forceinline__ unsigned cvt_pk_bf16(float lo, float hi) { unsigned r; asm volatile("v_cvt_pk_bf16_f32 %0, %1, %2" : "=v"(r) : "v"(lo), "v"(hi)); return r; }
template <class Epi, class Sched>
__device__ __forceinline__ void gemm_phase(PG8_LAS unsigned char* lds, const Gemm g, const Sched& S, const Epi& E) {
    int tid = threadIdx.x; asm volatile("" : "+v"(tid)); const int wid = __builtin_amdgcn_readfirstlane(tid >> 6), lane = tid & 63, wr = wid >> 2, wc = wid & 3, fr = lane & 15, fq = lane >> 4;
    const int K = g.K, nt = K / BK;
    unsigned voffA[2], voffB[2];
#pragma unroll
    for (int i = 0; i < 2; ++i) { int R, C; stage_rc(tid * 16 + i * 8192, R, C); const int Rb = Epi::PERM ? ((R & ~31) + perm32(R & 31)) : R;
        voffA[i] = (unsigned)(R * K + C) * 2u; voffB[i] = (unsigned)(Rb * K + C) * 2u; }
    const size_t kstep = (size_t)(BK * 2);
    const size_t hstep = (size_t)HALF * K * 2;
    const size_t tstep = 2 * hstep;
    const unsigned ldsw = (unsigned)wid * 1024u;
    const int aoff = lds_byte(wr * 64 + fr, fq * 8), boff = lds_byte(wc * 32 + fr, fq * 8);
#define PG8_SA(b, h) (((b) * 2 + (h)) * HTB)
#define PG8_SB(b, h) ((4 + (b) * 2 + (h)) * HTB)
#define PG8_STAGE(bufoff, gbase, voff, AUX) do { _Pragma("unroll") for (int _i = 0; _i < 2; ++_i) \
        __builtin_amdgcn_global_load_lds((const unsigned*)((const char*)(gbase) + (voff)[_i]), (PG8_LAS unsigned*)(lds + (bufoff) + ldsw + _i * 8192), 16, 0, AUX); } while (0)
#define PG8_LDA(dst, b, h) do { _Pragma("unroll") for (int m = 0; m < 4; ++m) _Pragma("unroll") for (int k = 0; k < 2; ++k) dst[m][k] = *(const PG8_LAS bf16x8*)(lds + PG8_SA(b, h) + aoff + m * 2048 + k * 1024); } while (0)
#define PG8_LDB(dst, b, h) do { _Pragma("unroll") for (int n = 0; n < 2; ++n) _Pragma("unroll") for (int k = 0; k < 2; ++k) dst[n][k] = *(const PG8_LAS bf16x8*)(lds + PG8_SB(b, h) + boff + n * 2048 + k * 1024); } while (0)
#define PG8_MMA(ai, bj, At, Bt) do { __builtin_amdgcn_s_setprio(1); _Pragma("unroll") for (int m = 0; m < 4; ++m) _Pragma("unroll") for (int n = 0; n < 2; ++n) _Pragma("unroll") for (int k = 0; k < 2; ++k) \
        acc[ai][bj][m][n] = __builtin_amdgcn_mfma_f32_16x16x32_bf16(Bt[n][k], At[m][k], acc[ai][bj][m][n], 0, 0, 0); __builtin_amdgcn_s_setprio(0); } while (0)
#define PG8_WAIT_V(n) asm volatile("s_waitcnt vmcnt(" #n ")" ::: "memory")
#define PG8_WAIT_L(n) asm volatile("s_waitcnt lgkmcnt(" #n ")" ::: "memory")
#define PG8_BAR __builtin_amdgcn_s_barrier()
#define PG8_SCHED __builtin_amdgcn_sched_barrier(0)
    Unit cur, nxt; int ui = 0;
    if (!S.next(0, cur)) return;
    f32x4 acc[2][2][4][2];
#pragma unroll
    for (int a = 0; a < 2; ++a)
#pragma unroll
        for (int b = 0; b < 2; ++b)
#pragma unroll
            for (int m = 0; m < 4; ++m)
#pragma unroll
                for (int n = 0; n < 2; ++n) acc[a][b][m][n] = (f32x4){0.f, 0.f, 0.f, 0.f};
    bf16x8 At[4][2], B0[2][2], B1[2][2];
    const char* cA = (const char*)g.A + (size_t)cur.pm * tstep; const char* cB = (const char*)g.Bt + (size_t)cur.pn * tstep + (size_t)seq_of_pm(cur.pm) * g.bseq;
    S.a_ready(cur);
    PG8_STAGE(PG8_SB(0, 0), cB, voffB, Epi::B_AUX); PG8_STAGE(PG8_SA(0, 0), cA, voffA, Epi::A_AUX); PG8_STAGE(PG8_SB(0, 1), cB + hstep, voffB, Epi::B_AUX); PG8_STAGE(PG8_SA(0, 1), cA + hstep, voffA, Epi::A_AUX);
    if (wr == 1) PG8_BAR;
    PG8_WAIT_V(4); PG8_BAR;
    PG8_STAGE(PG8_SB(1, 0), cB + kstep, voffB, Epi::B_AUX); PG8_STAGE(PG8_SA(1, 0), cA + kstep, voffA, Epi::A_AUX); PG8_STAGE(PG8_SB(1, 1), cB + hstep + kstep, voffB, Epi::B_AUX);
    PG8_STAGE(PG8_SA(1, 1), cA + hstep + kstep, voffA, Epi::A_AUX);
    PG8_WAIT_V(8); PG8_BAR;
    for (;;) {
        const bool has_next = S.next(ui + 1, nxt);
        const char* nA = has_next ? (const char*)g.A + (size_t)nxt.pm * tstep : cA + (size_t)(nt - 2) * kstep; const char* nB = has_next ? (const char*)g.Bt + (size_t)nxt.pn * tstep + (size_t)seq_of_pm(nxt.pm) * g.bseq : cB + (size_t)(nt - 2) * kstep;
        for (int t = 0; t < nt; t += 2) {
            const bool last = (t == nt - 2);
            const char* a2 = last ? nA : cA + (size_t)(t + 2) * kstep; const char* b2 = last ? nB : cB + (size_t)(t + 2) * kstep;
            const char* a3 = a2 + kstep; const char* b3 = b2 + kstep;
            if (last && has_next) S.a_ready(nxt);
            PG8_LDB(B0, 0, 0); PG8_SCHED; PG8_LDA(At, 0, 0);
            PG8_WAIT_L(8); PG8_BAR; PG8_WAIT_L(0); PG8_MMA(0, 0, At, B0); PG8_BAR; PG8_SCHED;
            PG8_LDB(B1, 0, 1); PG8_STAGE(PG8_SB(0, 0), b2, voffB, Epi::B_AUX);
            PG8_BAR; PG8_WAIT_L(0); PG8_MMA(0, 1, At, B1); PG8_BAR;
            PG8_LDA(At, 0, 1); PG8_STAGE(PG8_SA(0, 0), a2, voffA, Epi::A_AUX);
            PG8_BAR; PG8_WAIT_L(0); PG8_MMA(1, 0, At, B0); PG8_BAR; PG8_SCHED;
            PG8_STAGE(PG8_SB(0, 1), b2 + hstep, voffB, Epi::B_AUX);
            { const int relax = __builtin_amdgcn_readfirstlane((t == 0 && ui > 0) ? 1 : 0);
              asm volatile("s_cmp_eq_u32 %0, 0\n\ts_cbranch_scc1 .Lpg8w6_%=\n\ts_waitcnt vmcnt(%1)\n\ts_branch .Lpg8wd_%=\n.Lpg8w6_%=:\n\ts_waitcnt vmcnt(6)\n.Lpg8wd_%=:" :: "s"(relax), "n"(6 + Epi::TAIL_STORES) : "scc", "memory"); }
            PG8_BAR; PG8_MMA(1, 1, At, B1); PG8_BAR;
            PG8_LDB(B0, 1, 0); PG8_SCHED; PG8_LDA(At, 1, 0); PG8_STAGE(PG8_SA(0, 1), a2 + hstep, voffA, Epi::A_AUX);
            PG8_WAIT_L(8); PG8_BAR; PG8_WAIT_L(0); PG8_MMA(0, 0, At, B0); PG8_BAR; PG8_SCHED;
            PG8_LDB(B1, 1, 1); PG8_STAGE(PG8_SB(1, 0), b3, voffB, Epi::B_AUX);
            PG8_BAR; PG8_WAIT_L(0); PG8_MMA(0, 1, At, B1); PG8_BAR;
            PG8_LDA(At, 1, 1); PG8_STAGE(PG8_SA(1, 0), a3, voffA, Epi::A_AUX);
            PG8_BAR; PG8_WAIT_L(0); PG8_MMA(1, 0, At, B0); PG8_BAR; PG8_SCHED;
            PG8_STAGE(PG8_SB(1, 1), b3 + hstep, voffB, Epi::B_AUX);
            PG8_WAIT_V(6); PG8_BAR; PG8_MMA(1, 1, At, B1); PG8_BAR;
            PG8_STAGE(PG8_SA(1, 1), a3 + hstep, voffA, Epi::A_AUX);
        }
        if constexpr (!Epi::AFTER_DRAIN) { E(acc, cur, wr, wc, fr, fq); S.done(cur); }
        if (!has_next) break;
#pragma unroll
        for (int a = 0; a < 2; ++a)
#pragma unroll
            for (int b = 0; b < 2; ++b)
#pragma unroll
                for (int m = 0; m < 4; ++m)
#pragma unroll
                    for (int n = 0; n < 2; ++n) acc[a][b][m][n] = (f32x4){0.f, 0.f, 0.f, 0.f};
        cur = nxt; cA = nA; cB = nB; ++ui;
    }
    PG8_WAIT_V(0);
    if (wr == 0) PG8_BAR;
    PG8_BAR;
    if constexpr (Epi::AFTER_DRAIN) { E.fused(acc, cur, wr, wc, fr, fq, lds, wid, lane); S.done(cur); }
#undef PG8_SA
#undef PG8_SB
#undef PG8_STAGE
#undef PG8_LDA
#undef PG8_LDB
#undef PG8_MMA
#undef PG8_WAIT_V
#undef PG8_WAIT_L
#undef PG8_BAR
#undef PG8_SCHED
}
}


using pg8::bf16_t; using pg8::bf16x8; using pg8::f32x4; using pg8::u32x4; using pg8::Unit;
typedef unsigned u32x2 __attribute__((ext_vector_type(2)));
#define LAS PG8_LAS
constexpr int T_TOK = 98304, T_P = 65536, DM = 1024, DFF = 2816;
constexpr int LDS_BYTES = 131072 + 16;
constexpr float EPSV = 1e-6f;

constexpr size_t WS_WAB_IN = 0;
constexpr size_t WS_WAB_OUT = WS_WAB_IN + (size_t)2560 * 1024 * 2;
constexpr size_t WS_WCD_IN = WS_WAB_OUT + (size_t)1024 * 1024 * 2;
constexpr size_t WS_WCD_OUT = WS_WCD_IN + (size_t)2048 * 1024 * 2;
constexpr size_t WS_WFFN_IN = WS_WCD_OUT + (size_t)1024 * 1024 * 2;
constexpr size_t WS_WFFN_OUT = WS_WFFN_IN + (size_t)2 * 5632 * 1024 * 2;
constexpr size_t WS_WS = WS_WFFN_OUT + (size_t)2 * 1024 * 2816 * 2;
constexpr size_t WS_MOD = WS_WS + (size_t)6 * 128 * 128 * 2;
constexpr size_t WS_DFT1 = WS_MOD + (size_t)2 * 10 * 6144 * 4;
constexpr size_t WS_DFT2A = WS_DFT1 + (size_t)256 * 256 * 2;
constexpr size_t WS_DFT2B = WS_DFT2A + (size_t)64 * 128 * 2;
constexpr size_t WS_H = WS_DFT2B + (size_t)128 * 256 * 2;
constexpr size_t WS_P = WS_H + (size_t)T_TOK * 1024 * 2;
constexpr size_t WS_Y1 = WS_P + (size_t)T_TOK * 2048 * 2;
constexpr size_t WS_RP = WS_P + (size_t)T_TOK * 2816 * 2;
constexpr size_t WS_BIAS = WS_RP + (size_t)4 * T_TOK * 16 * 4;
constexpr size_t WS_WF0 = WS_BIAS + (size_t)10 * (5632 + 2048 + 5632) * 4;
constexpr size_t WS_BAR = WS_WF0 + (size_t)10 * 5632 * 1024 * 2;
constexpr size_t WS_END = WS_BAR + 16384;
constexpr size_t DO_U = 0;
constexpr size_t DO_WCD = DO_U + (size_t)T_TOK * 1024 * 2;
constexpr size_t DO_WF1 = DO_WCD + (size_t)10 * 2048 * 1024 * 2;
constexpr size_t DO_END = DO_WF1 + (size_t)10 * 5632 * 1024 * 2;
static_assert(DO_END <= (size_t)T_TOK * 1024 * 4, "d_out scratch overflow");

#ifndef PROBE_SYNCS
#define PROBE_SYNCS 0
#endif
#ifndef PROBE_SG
#define PROBE_SG 0
#endif
#ifndef PROBE_HOT
#define PROBE_HOT 0
#endif
#ifndef PROBE_MASK
#define PROBE_MASK 0
#endif
struct Params { const float* in[24]; float* out; unsigned char* ws; int ph_lo, ph_hi; };

__device__ __forceinline__ int tid_opaque() { int t = threadIdx.x; asm volatile("" : "+v"(t)); return t; }
__device__ __forceinline__ int seq_of(int row) { return row < T_P ? (row >> 13) : 8 + ((row - T_P) >> 14); }
__device__ __forceinline__ float bf2f(unsigned short b) { return __uint_as_float(((unsigned)b) << 16); }
__device__ __forceinline__ unsigned pk2(float lo, float hi) { return pg8::cvt_pk_bf16(lo, hi); }
__device__ __forceinline__ float sigm(float x) { return __builtin_amdgcn_rcpf(1.0f + __builtin_amdgcn_exp2f(-1.44269504f * x)); }
__device__ __forceinline__ float wave_sum(float v) {
#pragma unroll
    for (int o = 32; o >= 1; o >>= 1) v += __shfl_xor(v, o);
    return v;
}

template <int KIND> struct EpiAct {
    static constexpr bool PERM = true, AFTER_DRAIN = false; static constexpr int A_AUX = 0, B_AUX = 0;
    static constexpr int TAIL_STORES = (KIND == 2) ? 16 : 8;
    bf16_t* O; int ldc; const float* rowpart; const float* bias; int nbias;
    __device__ __forceinline__ void operator()(const f32x4 (&acc)[2][2][4][2], const Unit& u, int wr, int wc, int fr, int fq) const {
        asm volatile("" : "+v"(fr), "+v"(fq));
        const int row0 = u.pm * 256 + wr * 64 + fr;
        float rs[2][4]; f32x4 bv[2][2];
        if (rowpart) {
#pragma unroll
            for (int ai = 0; ai < 2; ++ai)
#pragma unroll
                for (int m = 0; m < 4; ++m) { const f32x4 pv = *(const f32x4*)(rowpart + (size_t)(row0 + ai * 128 + m * 16) * 16 + 4 * fq);
                    float ss = (pv[0] + pv[1]) + (pv[2] + pv[3]); ss += __shfl_xor(ss, 16); ss += __shfl_xor(ss, 32);
                    rs[ai][m] = __builtin_amdgcn_rsqf(ss * (1.0f / 1024.0f) + EPSV); }
            const float* bp = bias + (size_t)seq_of(u.pm * 256) * nbias + u.pn * 256 + wc * 32 + 8 * fq;
#pragma unroll
            for (int bj = 0; bj < 2; ++bj)
#pragma unroll
                for (int n = 0; n < 2; ++n) bv[bj][n] = *(const f32x4*)(bp + bj * 128 + 4 * n);
        } else {
#pragma unroll
            for (int ai = 0; ai < 2; ++ai)
#pragma unroll
                for (int m = 0; m < 4; ++m) rs[ai][m] = 1.0f;
#pragma unroll
            for (int bj = 0; bj < 2; ++bj)
#pragma unroll
                for (int n = 0; n < 2; ++n) bv[bj][n] = (f32x4){0.f, 0.f, 0.f, 0.f};
        }
        int mode, colbase;
        if (KIND == 2) { mode = 0; colbase = u.pn * 256; }
        else if (KIND == 1) { mode = 3; colbase = u.pn * 128; }
        else { if (u.pn < 2) { mode = 0; colbase = u.pn * 256; } else if (u.pn < 6) { mode = 1; colbase = 512 + (u.pn - 2) * 128; } else { mode = 2; colbase = 1024 + (u.pn - 6) * 128; } }
        const int col0 = colbase + wc * 32 + 8 * fq;
#pragma unroll
        for (int ai = 0; ai < 2; ++ai)
#pragma unroll
            for (int m = 0; m < 4; ++m) { bf16_t* rowp = O + (size_t)(row0 + ai * 128 + m * 16) * ldc + col0;
                const float sc = rs[ai][m];
                const f32x4 a0 = acc[ai][0][m][0] * sc + bv[0][0], a1 = acc[ai][0][m][1] * sc + bv[0][1], b0 = acc[ai][1][m][0] * sc + bv[1][0], b1 = acc[ai][1][m][1] * sc + bv[1][1];
                if (mode == 0) {
                    u32x4 w; w.x = pk2(a0[0], a0[1]); w.y = pk2(a0[2], a0[3]); w.z = pk2(a1[0], a1[1]); w.w = pk2(a1[2], a1[3]);
                    __builtin_nontemporal_store(w, (u32x4*)rowp);
                    w.x = pk2(b0[0], b0[1]); w.y = pk2(b0[2], b0[3]); w.z = pk2(b1[0], b1[1]); w.w = pk2(b1[2], b1[3]);
                    __builtin_nontemporal_store(w, (u32x4*)(rowp + 128));
                } else {
                    float r[8];
#pragma unroll
                    for (int j = 0; j < 4; ++j) {
                        if (mode == 1) { r[j] = a0[j] * b0[j]; r[4 + j] = a1[j] * b1[j]; }
                        else if (mode == 2) { r[j] = a0[j] * sigm(b0[j]); r[4 + j] = a1[j] * sigm(b1[j]); }
                        else { r[j] = a0[j] * sigm(a0[j]) * b0[j]; r[4 + j] = a1[j] * sigm(a1[j]) * b1[j]; } }
                    u32x4 w; w.x = pk2(r[0], r[1]); w.y = pk2(r[2], r[3]); w.z = pk2(r[4], r[5]); w.w = pk2(r[6], r[7]);
                    __builtin_nontemporal_store(w, (u32x4*)rowp); }
            }
    }
};
#ifndef RES_A_AUX
#define RES_A_AUX 0
#endif
template <bool SRC_F32> struct EpiRes {
    static constexpr int TAIL_STORES = 12;
    static constexpr bool PERM = true, AFTER_DRAIN = false; static constexpr int A_AUX = RES_A_AUX, B_AUX = 0;
    const float* src0; const float* src1; bf16_t* X; const float* gate; float* rowpart;
    __device__ __forceinline__ void operator()(const f32x4 (&acc)[2][2][4][2], const Unit& u, int wr, int wc, int fr, int fq) const {
        asm volatile("" : "+v"(fr), "+v"(fq));
        const int rowl = wr * 64 + fr, col0 = u.pn * 256 + wc * 32 + 8 * fq, rbase = u.pm * 256;
        const int seq = seq_of(rbase);
        const float* gp = gate + (size_t)seq * 6144 + col0;
        f32x4 gv[2][2];
#pragma unroll
        for (int bj = 0; bj < 2; ++bj)
#pragma unroll
            for (int n = 0; n < 2; ++n) gv[bj][n] = *(const f32x4*)(gp + bj * 128 + 4 * n);
        bf16_t* xb = X + (size_t)rbase * 1024 + col0;
        const float* sb = (rbase < T_P) ? src0 + (size_t)rbase * 1024 + col0 : src1 + (size_t)(rbase - T_P) * 1024 + col0;
#pragma unroll
        for (int ai = 0; ai < 2; ++ai) {
            f32x4 sv[4][2][2];
            if (SRC_F32) {
#pragma unroll
                for (int m = 0; m < 4; ++m)
#pragma unroll
                    for (int bj = 0; bj < 2; ++bj)
#pragma unroll
                        for (int n = 0; n < 2; ++n) sv[m][bj][n] = *(const f32x4*)(sb + (size_t)(rowl + ai * 128 + m * 16) * 1024 + bj * 128 + 4 * n);
            } else {
                u32x4 raw[4][2];
#pragma unroll
                for (int m = 0; m < 4; ++m)
#pragma unroll
                    for (int bj = 0; bj < 2; ++bj) raw[m][bj] = *(const u32x4*)(xb + (size_t)(rowl + ai * 128 + m * 16) * 1024 + bj * 128);
#pragma unroll
                for (int m = 0; m < 4; ++m)
#pragma unroll
                    for (int bj = 0; bj < 2; ++bj) { const u32x4 r = raw[m][bj];
                        sv[m][bj][0] = (f32x4){__uint_as_float(r.x << 16), __uint_as_float(r.x & 0xffff0000u), __uint_as_float(r.y << 16), __uint_as_float(r.y & 0xffff0000u)};
                        sv[m][bj][1] = (f32x4){__uint_as_float(r.z << 16), __uint_as_float(r.z & 0xffff0000u), __uint_as_float(r.w << 16), __uint_as_float(r.w & 0xffff0000u)}; }
            }
#pragma unroll
            for (int m = 0; m < 4; ++m) { const int rl = rowl + ai * 128 + m * 16; float ss = 0.f;
#pragma unroll
                for (int bj = 0; bj < 2; ++bj) { const f32x4 x0 = sv[m][bj][0] + gv[bj][0] * acc[ai][bj][m][0], x1 = sv[m][bj][1] + gv[bj][1] * acc[ai][bj][m][1];
                    ss += (x0[0] * x0[0] + x0[1] * x0[1]) + (x0[2] * x0[2] + x0[3] * x0[3]) + (x1[0] * x1[0] + x1[1] * x1[1]) + (x1[2] * x1[2] + x1[3] * x1[3]);
                    u32x4 w; w.x = pk2(x0[0], x0[1]); w.y = pk2(x0[2], x0[3]); w.z = pk2(x1[0], x1[1]); w.w = pk2(x1[2], x1[3]);
                    *(u32x4*)(xb + (size_t)rl * 1024 + bj * 128) = w; }
                ss += __shfl_xor(ss, 16); ss += __shfl_xor(ss, 32);
                if (fq == 0) rowpart[(size_t)(rbase + rl) * 16 + u.pn * 4 + wc] = ss; }
            asm volatile("" ::: "memory");
        }
    }
};

__device__ __forceinline__ int map_ab(int n0) {
    if (n0 < 512) return n0;
    if (n0 < 1536) { const int q = (n0 - 512) >> 8, r = (n0 - 512) & 255; return r < 128 ? 512 + 128 * q + r : 1024 + 128 * q + (r - 128); }
    const int q = (n0 - 1536) >> 8, r = (n0 - 1536) & 255; return r < 128 ? 1536 + 128 * q + r : 2048 + 128 * q + (r - 128);
}
__device__ __forceinline__ int map_ffn(int n0) { const int q = n0 >> 8, r = n0 & 255; return r < 128 ? 128 * q + r : 2816 + 128 * q + (r - 128); }

__device__ __forceinline__ void tile_load(const float* __restrict__ src, int ld, int c0, int k0, float* tile) {
    const int tid = tid_opaque();
#pragma unroll
    for (int p = 0; p < 2; ++p) { const int r = (tid >> 4) + p * 32, c4 = (tid & 15) * 4;
        const f32x4 v = *(const f32x4*)(src + (size_t)(k0 + r) * ld + c0 + c4);
        float* t = tile + r * 65 + c4; t[0] = v[0]; t[1] = v[1]; t[2] = v[2]; t[3] = v[3]; }
}
__device__ __forceinline__ void tile_store_t(const float* tile, bf16_t* __restrict__ dst, int ldd, int n0, int k0) {
    const int tid = tid_opaque(), n = tid >> 3, k8 = (tid & 7) * 8;
    float f[8];
#pragma unroll
    for (int i = 0; i < 8; ++i) f[i] = tile[(k8 + i) * 65 + n];
    u32x4 w; w.x = pk2(f[0], f[1]); w.y = pk2(f[2], f[3]); w.z = pk2(f[4], f[5]); w.w = pk2(f[6], f[7]);
    *(u32x4*)(dst + (size_t)(n0 + n) * ldd + k0 + k8) = w;
}

__device__ void phase_prep(const Params& p, unsigned char* smem) {
    const int tid = tid_opaque(), lane = tid & 63, wave = tid >> 6, G = gridDim.x, bid = blockIdx.x;
    unsigned char* ws = p.ws;
    {
        float* sc = (float*)smem;
        float* red = sc + 10240;
        bool have = false;
        for (int task = bid; task < 192; task += G) {
            if (!have) { for (int i = tid; i < 10240; i += 512) { const float c = i < 8192 ? p.in[2][i] : p.in[3][i - 8192]; sc[i] = c * sigm(c); } have = true; }
            __syncthreads();
            const int l = task / 96, cb = task % 96, j = cb * 64 + lane;
            const float* W = p.in[4] + (size_t)l * 1024 * 6144 + j;
            float acc[10];
#pragma unroll
            for (int s = 0; s < 10; ++s) acc[s] = 0.f;
            const int kbeg = wave * 128;
#pragma unroll 8
            for (int k = 0; k < 128; ++k) { const float w = W[(size_t)(kbeg + k) * 6144];
#pragma unroll
                for (int s = 0; s < 10; ++s) acc[s] = fmaf(sc[s * 1024 + kbeg + k], w, acc[s]); }
#pragma unroll
            for (int s = 0; s < 10; ++s) red[(wave * 10 + s) * 64 + lane] = acc[s];
            __syncthreads();
            for (int i = tid; i < 640; i += 512) { const int s = i >> 6, ln = i & 63; float v = 0.f;
#pragma unroll
                for (int w = 0; w < 8; ++w) v += red[(w * 10 + s) * 64 + ln];
                const int jj = cb * 64 + ln; v += p.in[5][l * 6144 + jj];
                const int chunk = jj >> 10, d = jj & 1023;
                if (chunk == 1) v = p.in[6][l * 1024 + d] * (1.0f + v); else if (chunk == 4) v = p.in[7][l * 1024 + d] * (1.0f + v);
                ((float*)(ws + WS_MOD))[(size_t)(l * 10 + s) * 6144 + jj] = v; }
            __syncthreads();
        }
        __syncthreads();
    }
    {
        const int gt = bid * 512 + tid, gn = G * 512;
        bf16_t* wsb = (bf16_t*)(ws + WS_WS);
        for (int i = gt; i < 6 * 128 * 128 / 2; i += gn) ((unsigned*)wsb)[i] = pk2(p.in[18][2 * i], p.in[18][2 * i + 1]);
        bf16_t* d1 = (bf16_t*)(ws + WS_DFT1);
        for (int i = gt; i < 256 * 256 / 2; i += gn) { float v[2];
#pragma unroll
            for (int e = 0; e < 2; ++e) { const int idx = 2 * i + e, m = idx >> 8, k = idx & 255, po = m >> 7, ka = m & 127, pi = k >> 7, a = k & 127;
                const float rev = (float)((ka * a) & 127) * (1.0f / 128.0f); const float c = __builtin_amdgcn_cosf(rev), s = __builtin_amdgcn_sinf(rev);
                v[e] = po == 0 ? (pi == 0 ? c : -s) : (pi == 0 ? -s : -c); }
            ((unsigned*)d1)[i] = pk2(v[0], v[1]); }
        bf16_t* d2a = (bf16_t*)(ws + WS_DFT2A);
        for (int i = gt; i < 64 * 128 / 2; i += gn) { float v[2];
#pragma unroll
            for (int e = 0; e < 2; ++e) { const int idx = 2 * i + e, kb = idx >> 7, k = idx & 127, pi = k >> 6, b = k & 63;
                const float rev = (float)((kb * b) & 63) * (1.0f / 64.0f); v[e] = pi == 0 ? __builtin_amdgcn_cosf(rev) : __builtin_amdgcn_sinf(rev); }
            ((unsigned*)d2a)[i] = pk2(v[0], v[1]); }
        bf16_t* d2b = (bf16_t*)(ws + WS_DFT2B);
        for (int i = gt; i < 128 * 256 / 2; i += gn) { float v[2];
#pragma unroll
            for (int e = 0; e < 2; ++e) { const int idx = 2 * i + e, kb = idx >> 8, k = idx & 255, pi = k >> 7, b = k & 127;
                const float rev = (float)((kb * b) & 127) * (1.0f / 128.0f); v[e] = pi == 0 ? __builtin_amdgcn_cosf(rev) : __builtin_amdgcn_sinf(rev); }
            ((unsigned*)d2b)[i] = pk2(v[0], v[1]); }
    }
    {
        float* tile = (float*)smem;
        float* trig = tile + 64 * 65;
        if (tid < 64) { const float rev = (float)tid * (1.0f / 64.0f); trig[tid] = __builtin_amdgcn_cosf(rev); trig[64 + tid] = __builtin_amdgcn_sinf(rev); }
        __syncthreads();
        for (int id = bid; id < 5824; id += G) {
            const float* src; int ld, c0, k0, n0, ldd; bf16_t* dst; bool fold = false; int fg = 0;
            if (id < 640) { const int kt = id & 15, nt = id >> 4; src = p.in[8]; ld = 2560; k0 = kt * 64; n0 = nt * 64; c0 = map_ab(n0); dst = (bf16_t*)(ws + WS_WAB_IN); ldd = 1024; }
            else if (id < 896) { const int i2 = id - 640, kt = i2 & 15, nt = i2 >> 4; src = p.in[14]; ld = 1024; k0 = kt * 64; n0 = nt * 64; c0 = n0; dst = (bf16_t*)(ws + WS_WAB_OUT); ldd = 1024; }
            else if (id < 1280) { const int i2 = id - 896, kt = i2 & 15, nt = i2 >> 4; src = p.in[15]; ld = 1792; k0 = kt * 64; n0 = nt * 64; c0 = n0; dst = (bf16_t*)(ws + WS_WCD_IN); ldd = 1024; }
            else if (id < 1344) { const int i2 = id - 1280, kt = i2 & 15; fg = i2 >> 4; src = p.in[15]; ld = 1792; k0 = kt * 64; n0 = 0; c0 = 1536 + 64 * fg; dst = (bf16_t*)(ws + WS_WCD_IN); ldd = 1024; fold = true; }
            else if (id < 1600) { const int i2 = id - 1344, kt = i2 & 15, nt = i2 >> 4; src = p.in[20]; ld = 1024; k0 = kt * 64; n0 = nt * 64; c0 = n0; dst = (bf16_t*)(ws + WS_WCD_OUT); ldd = 1024; }
            else if (id < 4416) { const int i2 = id - 1600, l = i2 / 1408, i3 = i2 % 1408, kt = i3 & 15, nt = i3 >> 4; src = p.in[21] + (size_t)l * 1024 * 5632; ld = 5632; k0 = kt * 64; n0 = nt * 64; c0 = map_ffn(n0);
                dst = (bf16_t*)(ws + WS_WFFN_IN) + (size_t)l * 5632 * 1024; ldd = 1024; }
            else { const int i2 = id - 4416, l = i2 / 704, i3 = i2 % 704, kt = i3 % 44, nt = i3 / 44; src = p.in[22] + (size_t)l * 2816 * 1024; ld = 1024; k0 = kt * 64; n0 = nt * 64; c0 = n0;
                dst = (bf16_t*)(ws + WS_WFFN_OUT) + (size_t)l * 1024 * 2816; ldd = 2816; }
            tile_load(src, ld, c0, k0, tile);
            __syncthreads();
            if (!fold) tile_store_t(tile, dst, ldd, n0, k0);
            else {
                const int np = tid >> 2, part = np >> 6, k2 = np & 63, kq = tid & 3;
                const float* tr = trig + part * 64;
                float a[16];
#pragma unroll
                for (int i = 0; i < 16; ++i) a[i] = 0.f;
                for (int n2 = 0; n2 < 64; ++n2) { const float t = tr[(k2 * n2) & 63];
#pragma unroll
                    for (int i = 0; i < 16; ++i) a[i] = fmaf(tile[(kq * 16 + i) * 65 + n2], t, a[i]); }
                bf16_t* dp = dst + (size_t)(1536 + part * 256 + fg * 64 + k2) * 1024 + k0 + kq * 16;
                u32x4 w0, w1;
                w0.x = pk2(a[0], a[1]); w0.y = pk2(a[2], a[3]); w0.z = pk2(a[4], a[5]); w0.w = pk2(a[6], a[7]);
                w1.x = pk2(a[8], a[9]); w1.y = pk2(a[10], a[11]); w1.z = pk2(a[12], a[13]); w1.w = pk2(a[14], a[15]);
                *(u32x4*)dp = w0; *(u32x4*)(dp + 8) = w1;
            }
            __syncthreads();
        }
    }
}

__device__ void phase_norm(const float* src0, const float* src1, const float* modl, int chA, int chB, bf16_t* H) {
    const int tid = tid_opaque(), lane = tid & 63, wave = tid >> 6;
    const int nw = gridDim.x * 8;
    for (int row = blockIdx.x * 8 + wave; row < T_TOK; row += 2 * nw) {
        f32x4 v[2][4]; float ss[2];
#pragma unroll
        for (int r = 0; r < 2; ++r) { const int rr = (row + r * nw < T_TOK) ? row + r * nw : row;
            const float* xp = rr < T_P ? src0 + (size_t)rr * 1024 : src1 + (size_t)(rr - T_P) * 1024;
#pragma unroll
            for (int i = 0; i < 4; ++i) v[r][i] = *(const f32x4*)(xp + i * 256 + lane * 4); }
#pragma unroll
        for (int r = 0; r < 2; ++r) { float s = 0.f;
#pragma unroll
            for (int i = 0; i < 4; ++i) s += v[r][i][0] * v[r][i][0] + v[r][i][1] * v[r][i][1] + v[r][i][2] * v[r][i][2] + v[r][i][3] * v[r][i][3];
            ss[r] = wave_sum(s); }
#pragma unroll
        for (int r = 0; r < 2; ++r) { const int rr = row + r * nw; if (rr >= T_TOK) break;
            const float rstd = __builtin_amdgcn_rsqf(ss[r] * (1.0f / 1024.0f) + EPSV);
            const float* mp = modl + (size_t)seq_of(rr) * 6144;
#pragma unroll
            for (int i = 0; i < 4; ++i) { const f32x4 A = *(const f32x4*)(mp + chA * 1024 + i * 256 + lane * 4), B = *(const f32x4*)(mp + chB * 1024 + i * 256 + lane * 4);
                const f32x4 h = v[r][i] * rstd * A + B; u32x2 w; w.x = pk2(h[0], h[1]); w.y = pk2(h[2], h[3]);
                *(u32x2*)(H + (size_t)rr * 1024 + i * 256 + lane * 4) = w; } }
    }
}
__device__ void phase_final(float* out, const bf16_t* X, const float* rowpart, const float* g) {
    const int tid = tid_opaque(), lane = tid & 63, wave = tid >> 6;
    const int nw = gridDim.x * 8;
    f32x4 gv[4];
#pragma unroll
    for (int i = 0; i < 2; ++i) { gv[2 * i] = *(const f32x4*)(g + i * 512 + lane * 8); gv[2 * i + 1] = *(const f32x4*)(g + i * 512 + lane * 8 + 4); }
    for (int row = blockIdx.x * 8 + wave; row < T_TOK; row += 2 * nw) {
        u32x4 v[2][2]; f32x4 pp[2][4];
#pragma unroll
        for (int r = 0; r < 2; ++r) { const int rr = (row + r * nw < T_TOK) ? row + r * nw : row;
#pragma unroll
            for (int i = 0; i < 2; ++i) v[r][i] = *(const u32x4*)(X + (size_t)rr * 1024 + i * 512 + lane * 8);
#pragma unroll
            for (int i = 0; i < 4; ++i) pp[r][i] = *(const f32x4*)(rowpart + (size_t)rr * 16 + i * 4); }
#pragma unroll
        for (int r = 0; r < 2; ++r) { const int rr = row + r * nw; if (rr >= T_TOK) break;
            float ss = 0.f;
#pragma unroll
            for (int i = 0; i < 4; ++i) ss += (pp[r][i][0] + pp[r][i][1]) + (pp[r][i][2] + pp[r][i][3]);
            const float rstd = __builtin_amdgcn_rsqf(ss * (1.0f / 1024.0f) + EPSV);
            float* xp = out + (size_t)rr * 1024;
#pragma unroll
            for (int i = 0; i < 2; ++i) { const u32x4 q = v[r][i];
                const f32x4 a = (f32x4){__uint_as_float(q.x << 16), __uint_as_float(q.x & 0xffff0000u), __uint_as_float(q.y << 16), __uint_as_float(q.y & 0xffff0000u)};
                const f32x4 b = (f32x4){__uint_as_float(q.z << 16), __uint_as_float(q.z & 0xffff0000u), __uint_as_float(q.w << 16), __uint_as_float(q.w & 0xffff0000u)};
                *(f32x4*)(xp + i * 512 + lane * 8) = a * rstd * gv[2 * i]; *(f32x4*)(xp + i * 512 + lane * 8 + 4) = b * rstd * gv[2 * i + 1]; } }
    }
}
__device__ __forceinline__ void tile_store_scaled(const float* tile, bf16_t* __restrict__ dst, size_t seqstride, const float* __restrict__ avec, int n0, int k0) {
    const int tid = threadIdx.x, n = tid >> 3, k8 = (tid & 7) * 8;
    float f[8];
#pragma unroll
    for (int i = 0; i < 8; ++i) f[i] = tile[(k8 + i) * 65 + n];
#pragma unroll 2
    for (int sq = 0; sq < 10; ++sq) { const f32x4 a0 = *(const f32x4*)(avec + (size_t)sq * 6144 + k0 + k8), a1 = *(const f32x4*)(avec + (size_t)sq * 6144 + k0 + k8 + 4);
        u32x4 w; w.x = pk2(f[0] * a0[0], f[1] * a0[1]); w.y = pk2(f[2] * a0[2], f[3] * a0[3]); w.z = pk2(f[4] * a1[0], f[5] * a1[1]); w.w = pk2(f[6] * a1[2], f[7] * a1[3]);
        *(u32x4*)(dst + (size_t)sq * seqstride + (size_t)(n0 + n) * 1024 + k0 + k8) = w; }
}
__device__ void phase_wscaled(const Params& p, unsigned char* smem) {
    const int tid = tid_opaque();
    const float* mod = (const float*)(p.ws + WS_MOD);
    float* av = (float*)smem;
#pragma unroll 1
    for (int c = 0; c < 3; ++c) {
        const int N = (c == 1) ? 2048 : 5632;
        const float* avec = c == 0 ? mod + 4 * 1024 : c == 1 ? mod + 61440 + 1 * 1024 : mod + 61440 + 4 * 1024;
        const bf16_t* Bt = c == 0 ? (const bf16_t*)(p.ws + WS_WFFN_IN) : c == 1 ? (const bf16_t*)(p.ws + WS_WCD_IN) : (const bf16_t*)(p.ws + WS_WFFN_IN) + (size_t)5632 * 1024;
        bf16_t* dst = c == 0 ? (bf16_t*)(p.ws + WS_WF0) : c == 1 ? (bf16_t*)((unsigned char*)p.out + DO_WCD) : (bf16_t*)((unsigned char*)p.out + DO_WF1);
        const size_t sstr = (size_t)N * 1024;
        __syncthreads();
        for (int i = tid; i < 10240; i += 512) av[i] = avec[(size_t)(i >> 10) * 6144 + (i & 1023)];
        __syncthreads();
        const int nchunk = N * 128;
        for (int ch = blockIdx.x * 512 + tid; ch < nchunk; ch += gridDim.x * 512) {
            const int k8 = (ch & 127) * 8;
            const u32x4 wv = *(const u32x4*)(Bt + (size_t)ch * 8);
            float f[8];
#pragma unroll
            for (int e = 0; e < 4; ++e) { f[2 * e] = __uint_as_float(wv[e] << 16); f[2 * e + 1] = __uint_as_float(wv[e] & 0xffff0000u); }
#pragma unroll
            for (int sq = 0; sq < 10; ++sq) { const f32x4 a0 = *(const f32x4*)(av + sq * 1024 + k8), a1 = *(const f32x4*)(av + sq * 1024 + k8 + 4);
                u32x4 w; w.x = pk2(f[0] * a0[0], f[1] * a0[1]); w.y = pk2(f[2] * a0[2], f[3] * a0[3]); w.z = pk2(f[4] * a1[0], f[5] * a1[1]); w.w = pk2(f[6] * a1[2], f[7] * a1[3]);
                *(u32x4*)(dst + (size_t)sq * sstr + (size_t)ch * 8) = w; }
        }
    }
    __syncthreads();
}
__device__ void phase_bias(const Params& p, unsigned char* smem) {
    const int tid = tid_opaque(), lane = tid & 63, wave = tid >> 6, nw = gridDim.x * 8;
    float* sh = (float*)smem;
    const float* mod = (const float*)(p.ws + WS_MOD);
    float* biasb = (float*)(p.ws + WS_BIAS);
#pragma unroll 1
    for (int c = 0; c < 3; ++c) {
        const int N = (c == 1) ? 2048 : 5632;
        const float* shp = mod + (size_t)(c == 0 ? 0 : 1) * 61440 + (c == 1 ? 0 : 3) * 1024;
        const bf16_t* Bt = c == 0 ? (const bf16_t*)(p.ws + WS_WFFN_IN) : c == 1 ? (const bf16_t*)(p.ws + WS_WCD_IN) : (const bf16_t*)(p.ws + WS_WFFN_IN) + (size_t)5632 * 1024;
        float* bo = biasb + (c == 0 ? 0 : c == 1 ? 56320 : 56320 + 20480);
        __syncthreads();
        for (int i = tid; i < 10240; i += 512) sh[i] = shp[(size_t)(i >> 10) * 6144 + (i & 1023)];
        __syncthreads();
        for (int n = blockIdx.x * 8 + wave; n < N; n += nw) {
            const u32x4 w0 = *(const u32x4*)(Bt + (size_t)n * 1024 + lane * 16), w1 = *(const u32x4*)(Bt + (size_t)n * 1024 + lane * 16 + 8);
            float wf[16];
#pragma unroll
            for (int e = 0; e < 4; ++e) { wf[2 * e] = __uint_as_float(w0[e] << 16); wf[2 * e + 1] = __uint_as_float(w0[e] & 0xffff0000u); wf[8 + 2 * e] = __uint_as_float(w1[e] << 16); wf[8 + 2 * e + 1] = __uint_as_float(w1[e] & 0xffff0000u); }
            float my = 0.f;
#pragma unroll
            for (int sq = 0; sq < 10; ++sq) { float d = 0.f;
#pragma unroll
                for (int q = 0; q < 4; ++q) { const f32x4 b = *(const f32x4*)(sh + sq * 1024 + lane * 16 + q * 4); d += wf[q * 4] * b[0] + wf[q * 4 + 1] * b[1] + wf[q * 4 + 2] * b[2] + wf[q * 4 + 3] * b[3]; }
                d = wave_sum(d); if (lane == sq) my = d; }
            if (lane < 10) bo[(size_t)lane * N + n] = my;
        }
    }
    __syncthreads();
}

__device__ void phase_conv(const Params& p, unsigned char* smem) {
    const int tid = tid_opaque(), lane = tid & 63, wave = tid >> 6;
    const bf16_t* P0 = (const bf16_t*)(p.ws + WS_P);
    bf16_t* U = (bf16_t*)((unsigned char*)p.out + DO_U);
    bf16_t* gt = (bf16_t*)smem;
    float* zt = (float*)(smem + 94 * 1024);
    const float* wa = p.in[9];
    const float* wb = p.in[10];
    float w[31];
#pragma unroll
    for (int k = 0; k < 31; ++k) w[k] = wb[k * 512 + tid];
    const float bias = p.in[11][tid];
    float lg[8], lb[8];
#pragma unroll
    for (int i = 0; i < 8; ++i) { lg[i] = p.in[12][lane * 8 + i]; lb[i] = p.in[13][lane * 8 + i]; }
    const int ntiles = T_TOK / 64;
#define CONV_STAGE_LOAD(tile_, SG) do { const int t0_ = (tile_) * 64, seq_ = seq_of(t0_); \
        const int s0_ = seq_ < 8 ? seq_ * 8192 : T_P + (seq_ - 8) * 16384, s1_ = s0_ + (seq_ < 8 ? 8192 : 16384); \
        _Pragma("unroll") for (int j = 0; j < 12; ++j) { const int i = tid + 512 * j, r = i >> 6, ch = i & 63, tok = t0_ - 15 + r; \
            SG[j] = (u32x4){0u, 0u, 0u, 0u}; \
            if (i < 94 * 64 && tok >= s0_ && tok < s1_) SG[j] = *(const u32x4*)(P0 + (size_t)tok * 1536 + 1024 + ch * 8); } } while (0)
    u32x4 sg[12];
    if ((int)blockIdx.x < ntiles) CONV_STAGE_LOAD((int)blockIdx.x, sg);
    for (int tile = blockIdx.x; tile < ntiles; tile += gridDim.x) {
        const int t0 = tile * 64, seq = seq_of(t0);
        const int s0 = seq < 8 ? seq * 8192 : T_P + (seq - 8) * 16384, s1 = s0 + (seq < 8 ? 8192 : 16384);
#pragma unroll
        for (int j = 0; j < 12; ++j) { const int i = tid + 512 * j, r = i >> 6, ch = i & 63; if (i < 94 * 64) *(u32x4*)(gt + r * 512 + ch * 8) = sg[j]; }
        __syncthreads();
        if (tile + (int)gridDim.x < ntiles) CONV_STAGE_LOAD(tile + (int)gridDim.x, sg);
#pragma unroll 1
        for (int grp = 0; grp < 4; ++grp) {
            u32x4 yab[2], yx0[2], yxm[2], yxp[2];
#pragma unroll
            for (int j = 0; j < 2; ++j) { const int i = tid + 512 * j, t = grp * 16 + (i >> 6), ch = i & 63, tok = t0 + t, c0 = ch * 8;
                const bf16_t* rp = P0 + (size_t)tok * 1536;
                yab[j] = *(const u32x4*)(rp + c0); yx0[j] = *(const u32x4*)(rp + 512 + c0);
                yxm[j] = (u32x4){0u, 0u, 0u, 0u}; yxp[j] = (u32x4){0u, 0u, 0u, 0u};
                if (tok - 1 >= s0) yxm[j] = *(const u32x4*)(rp - 1536 + 512 + c0);
                if (tok + 1 < s1) yxp[j] = *(const u32x4*)(rp + 1536 + 512 + c0); }
            float g[46];
#pragma unroll
            for (int i = 0; i < 46; ++i) g[i] = bf2f(gt[(grp * 16 + i) * 512 + tid]);
#pragma unroll
            for (int t = 0; t < 16; ++t) { float a = bias;
#pragma unroll
                for (int k = 0; k < 31; ++k) a = fmaf(w[k], g[t + k], a);
                zt[t * 512 + tid] = a; }
            __syncthreads();
#pragma unroll
            for (int tt = 0; tt < 2; ++tt) { const int t = wave * 2 + tt;
                const f32x4 z0 = *(const f32x4*)(zt + t * 512 + lane * 8), z1 = *(const f32x4*)(zt + t * 512 + lane * 8 + 4);
                float s = (z0[0] + z0[1]) + (z0[2] + z0[3]) + (z1[0] + z1[1]) + (z1[2] + z1[3]);
                s = wave_sum(s); const float mu = s * (1.0f / 512.0f);
                const f32x4 d0 = z0 - mu, d1 = z1 - mu;
                float q = d0[0] * d0[0] + d0[1] * d0[1] + d0[2] * d0[2] + d0[3] * d0[3] + d1[0] * d1[0] + d1[1] * d1[1] + d1[2] * d1[2] + d1[3] * d1[3];
                q = wave_sum(q); const float rstd = __builtin_amdgcn_rsqf(q * (1.0f / 512.0f) + EPSV);
                float r[8];
#pragma unroll
                for (int e = 0; e < 8; ++e) { const float d = e < 4 ? d0[e & 3] : d1[e & 3]; const float y = d * rstd * lg[e] + lb[e]; r[e] = y * sigm(y); }
                u32x4 o; o.x = pk2(r[0], r[1]); o.y = pk2(r[2], r[3]); o.z = pk2(r[4], r[5]); o.w = pk2(r[6], r[7]);
                *(u32x4*)(U + (size_t)(t0 + grp * 16 + t) * 1024 + 512 + lane * 8) = o; }
#pragma unroll
            for (int j = 0; j < 2; ++j) { const int i = tid + 512 * j, t = grp * 16 + (i >> 6), ch = i & 63, tok = t0 + t, c0 = ch * 8;
                const u32x4 ab = yab[j], x0 = yx0[j], xm = yxm[j], xp = yxp[j];
                const f32x4 w0a = *(const f32x4*)(wa + c0), w0b = *(const f32x4*)(wa + c0 + 4), w1a = *(const f32x4*)(wa + 512 + c0), w1b = *(const f32x4*)(wa + 512 + c0 + 4),
                            w2a = *(const f32x4*)(wa + 1024 + c0), w2b = *(const f32x4*)(wa + 1024 + c0 + 4);
                float r[8];
#pragma unroll
                for (int e = 0; e < 8; ++e) { const unsigned sh = (e & 1) * 16; const int q = e >> 1;
                    const float fab = __uint_as_float((ab[q] >> sh) << 16), f0 = __uint_as_float((x0[q] >> sh) << 16), fm = __uint_as_float((xm[q] >> sh) << 16), fp = __uint_as_float((xp[q] >> sh) << 16);
                    const float k0 = e < 4 ? w0a[e & 3] : w0b[e & 3], k1 = e < 4 ? w1a[e & 3] : w1b[e & 3], k2 = e < 4 ? w2a[e & 3] : w2b[e & 3];
                    r[e] = fab * (k0 * fm + k1 * f0 + k2 * fp); }
                u32x4 o; o.x = pk2(r[0], r[1]); o.y = pk2(r[2], r[3]); o.z = pk2(r[4], r[5]); o.w = pk2(r[6], r[7]);
                *(u32x4*)(U + (size_t)tok * 1024 + c0) = o; }
            __syncthreads();
        }
    }
#undef CONV_STAGE_LOAD
}

__device__ void phase_sg(const Params& p, unsigned char* smem) {
    const int tid = tid_opaque(), lane = tid & 63, wave = tid >> 6, fr = lane & 15, fq = lane >> 4;
    const bf16_t* P1 = (const bf16_t*)(p.ws + WS_P);
    bf16_t* U = (bf16_t*)((unsigned char*)p.out + DO_U);
    const bf16_t* Wsb = (const bf16_t*)(p.ws + WS_WS);
    float* st = (float*)smem;
    bf16_t* vnT = (bf16_t*)(smem + 1024);
    constexpr int PITCH = 136;
    const int pp = wave * 16 + fr;
#define SG_LOAD(h_, WF, UU, BS, VA) do { \
        _Pragma("unroll") for (int kk = 0; kk < 4; ++kk) WF[kk] = *(const bf16x8*)(Wsb + (size_t)((h_) * 128 + pp) * 128 + kk * 32 + fq * 8); \
        _Pragma("unroll") for (int mt = 0; mt < 8; ++mt) UU[mt] = *(const u32x2*)(P1 + (size_t)(t0 + pp) * 2048 + (h_) * 128 + mt * 16 + 4 * fq); \
        BS = p.in[19][(h_) * 128 + pp]; \
        _Pragma("unroll") for (int j = 0; j < 4; ++j) { const int item = tid + 512 * j, q = item & 127, dc = item >> 7; VA[j] = *(const u32x4*)(P1 + (size_t)(t0 + q) * 2048 + 768 + (h_) * 128 + dc * 8); } \
    } while (0)
    for (int chunk = blockIdx.x; chunk < T_TOK / 128; chunk += gridDim.x) {
        const int t0 = chunk * 128;
        bf16x8 wfN[4]; u32x2 uuN[8]; float bsN; u32x4 vaN[4];
        SG_LOAD(0, wfN, uuN, bsN, vaN);
#pragma unroll 1
        for (int half = 0; half < 2; ++half) {
            u32x4 av[8], bv[8];
#pragma unroll
            for (int tt = 0; tt < 8; ++tt) { const int q = wave * 16 + half * 8 + tt; const bf16_t* vp = P1 + (size_t)(t0 + q) * 2048 + 768;
                av[tt] = *(const u32x4*)(vp + lane * 8); bv[tt] = (u32x4){0u, 0u, 0u, 0u}; if (lane < 32) bv[tt] = *(const u32x4*)(vp + 512 + lane * 8); }
#pragma unroll
            for (int tt = 0; tt < 8; ++tt) { const int q = wave * 16 + half * 8 + tt; const u32x4 a = av[tt], b = bv[tt];
                float s = 0.f, ss = 0.f;
#pragma unroll
                for (int e = 0; e < 4; ++e) { const float x0 = __uint_as_float(a[e] << 16), x1 = __uint_as_float(a[e] & 0xffff0000u), y0 = __uint_as_float(b[e] << 16), y1 = __uint_as_float(b[e] & 0xffff0000u);
                    s += (x0 + x1) + (y0 + y1); ss += (x0 * x0 + x1 * x1) + (y0 * y0 + y1 * y1); }
                s = wave_sum(s); ss = wave_sum(ss);
                const float mu = s * (1.0f / 768.0f); const float var = ss * (1.0f / 768.0f) - mu * mu;
                if (lane == 0) { st[q * 2] = mu; st[q * 2 + 1] = __builtin_amdgcn_rsqf(fmaxf(var, 0.f) + EPSV); } }
        }
        __syncthreads();
#pragma unroll
        for (int h = 0; h < 6; ++h) {
            bf16x8 wf[4]; u32x2 uu[8]; u32x4 va[4]; const float bsv = bsN;
#pragma unroll
            for (int i = 0; i < 4; ++i) { wf[i] = wfN[i]; va[i] = vaN[i]; }
#pragma unroll
            for (int i = 0; i < 8; ++i) uu[i] = uuN[i];
#pragma unroll
            for (int j = 0; j < 4; ++j) { const int item = tid + 512 * j, q = item & 127, dc = item >> 7;
                const u32x4 a = va[j];
                const float mu = st[q * 2], rs = st[q * 2 + 1];
                const float* lg = p.in[16] + h * 128 + dc * 8; const float* lb = p.in[17] + h * 128 + dc * 8;
#pragma unroll
                for (int e = 0; e < 8; ++e) { const float x = (e & 1) ? __uint_as_float(a[e >> 1] & 0xffff0000u) : __uint_as_float(a[e >> 1] << 16);
                    const float y = (x - mu) * rs * lg[e] + lb[e];
                    vnT[(dc * 8 + e) * PITCH + q] = (bf16_t)(pk2(y, 0.f) & 0xffffu); } }
            __syncthreads();
            if (h < 5) SG_LOAD(h + 1, wfN, uuN, bsN, vaN);
            const size_t tokoff = (size_t)(t0 + pp);
#pragma unroll
            for (int mt = 0; mt < 8; ++mt) { f32x4 acc = (f32x4){0.f, 0.f, 0.f, 0.f};
#pragma unroll
                for (int kk = 0; kk < 4; ++kk) { const bf16x8 af = *(const bf16x8*)(vnT + (mt * 16 + fr) * PITCH + kk * 32 + fq * 8);
                    acc = __builtin_amdgcn_mfma_f32_16x16x32_bf16(af, wf[kk], acc, 0, 0, 0); }
                const int col = h * 128 + mt * 16 + 4 * fq;
                const u32x2 u2 = uu[mt];
                const float u0 = __uint_as_float(u2.x << 16), u1 = __uint_as_float(u2.x & 0xffff0000u), u2f = __uint_as_float(u2.y << 16), u3 = __uint_as_float(u2.y & 0xffff0000u);
                u32x2 o; o.x = pk2(u0 * (acc[0] + bsv), u1 * (acc[1] + bsv)); o.y = pk2(u2f * (acc[2] + bsv), u3 * (acc[3] + bsv));
                *(u32x2*)(U + tokoff * 1024 + col) = o; }
            __syncthreads();
        }
    }
#undef SG_LOAD
}

__device__ void phase_fft1(const Params& p, unsigned char* smem) {
    const int tid = tid_opaque(), lane = tid & 63, wave = tid >> 6, fr = lane & 15, fq = lane >> 4;
    const bf16_t* P1 = (const bf16_t*)(p.ws + WS_P);
    bf16_t* Y1 = (bf16_t*)(p.ws + WS_Y1);
    const bf16_t* D1 = (const bf16_t*)(p.ws + WS_DFT1);
    bf16_t* BT = (bf16_t*)smem;
    constexpr int PITCH = 264;
    bf16x8 af[2][8];
#pragma unroll
    for (int i = 0; i < 2; ++i)
#pragma unroll
        for (int kk = 0; kk < 8; ++kk) af[i][kk] = *(const bf16x8*)(D1 + (size_t)(i * 128 + wave * 16 + fr) * 256 + kk * 32 + fq * 8);
#define F1_DECODE(u_, seq_, b_, cblk_, N2_, tokbase_) do { int rem_; \
        if ((u_) < 2048) { seq_ = (u_) >> 8; rem_ = (u_) & 255; N2_ = 64; tokbase_ = seq_ * 8192; } else { const int u2_ = (u_) - 2048; seq_ = 8 + (u2_ >> 9); rem_ = u2_ & 511; N2_ = 128; tokbase_ = T_P + (seq_ - 8) * 16384; } \
        b_ = rem_ >> 2; cblk_ = rem_ & 3; } while (0)
#define F1_LOAD(u_, V) do { int seq_, b_, cblk_, N2_, tb_; F1_DECODE(u_, seq_, b_, cblk_, N2_, tb_); \
        _Pragma("unroll") for (int j = 0; j < 4; ++j) { const int item = tid + 512 * j, a = item & 127, rest = item >> 7, part = rest >> 3, ch8 = rest & 7; \
            V[j] = *(const u32x4*)(P1 + (size_t)(tb_ + a * N2_ + b_) * 2048 + 1536 + part * 256 + cblk_ * 64 + ch8 * 8); } } while (0)
    u32x4 nx[4];
    if ((int)blockIdx.x < 3072) F1_LOAD((int)blockIdx.x, nx);
    for (int u = blockIdx.x; u < 3072; u += gridDim.x) {
        int seq, b, cblk, N2, tokbase; F1_DECODE(u, seq, b, cblk, N2, tokbase);
#pragma unroll
        for (int j = 0; j < 4; ++j) { const int item = tid + 512 * j, a = item & 127, rest = item >> 7, part = rest >> 3, ch8 = rest & 7;
            const u32x4 v = nx[j];
#pragma unroll
            for (int e = 0; e < 8; ++e) BT[(ch8 * 8 + e) * PITCH + part * 128 + a] = (bf16_t)((e & 1) ? (v[e >> 1] >> 16) : (v[e >> 1] & 0xffffu)); }
        __syncthreads();
        if (u + (int)gridDim.x < 3072) F1_LOAD(u + (int)gridDim.x, nx);
        f32x4 acc[2][4];
#pragma unroll
        for (int i = 0; i < 2; ++i)
#pragma unroll
            for (int nt = 0; nt < 4; ++nt) acc[i][nt] = (f32x4){0.f, 0.f, 0.f, 0.f};
#pragma unroll
        for (int kk = 0; kk < 8; ++kk)
#pragma unroll
            for (int nt = 0; nt < 4; ++nt) { const bf16x8 bfr = *(const bf16x8*)(BT + (nt * 16 + fr) * PITCH + kk * 32 + fq * 8);
                acc[0][nt] = __builtin_amdgcn_mfma_f32_16x16x32_bf16(bfr, af[0][kk], acc[0][nt], 0, 0, 0);
                acc[1][nt] = __builtin_amdgcn_mfma_f32_16x16x32_bf16(bfr, af[1][kk], acc[1][nt], 0, 0, 0); }
        const int ka = wave * 16 + fr, S = N2 * 128;
        const float rev = (float)((ka * b) & (S - 1)) / (float)S; const float cw = __builtin_amdgcn_cosf(rev), sw = __builtin_amdgcn_sinf(rev);
        bf16_t* yp = Y1 + (size_t)(tokbase + ka * N2 + b) * 512 + cblk * 64 + 4 * fq;
#pragma unroll
        for (int nt = 0; nt < 4; ++nt) { const f32x4 yr = acc[0][nt], yi = acc[1][nt];
            const f32x4 zr = yr * cw + yi * sw, zi = yi * cw - yr * sw;
            u32x2 o; o.x = pk2(zr[0], zr[1]); o.y = pk2(zr[2], zr[3]); *(u32x2*)(yp + nt * 16) = o;
            o.x = pk2(zi[0], zi[1]); o.y = pk2(zi[2], zi[3]); *(u32x2*)(yp + 256 + nt * 16) = o; }
        __syncthreads();
    }
#undef F1_LOAD
#undef F1_DECODE
}
__device__ void phase_fft2(const Params& p, unsigned char* smem) {
    const int tid = tid_opaque(), lane = tid & 63, wave = tid >> 6, fr = lane & 15, fq = lane >> 4;
    const bf16_t* Y1 = (const bf16_t*)(p.ws + WS_Y1);
    bf16_t* U = (bf16_t*)((unsigned char*)p.out + DO_U);
    bf16_t* BT = (bf16_t*)smem;
    constexpr int PITCH = 264;
#define F2_DECODE(u_, N2_, lg2_, tokbase_, ka_, cblk_) do { \
        if ((u_) < 4096) { N2_ = 64; lg2_ = 6; tokbase_ = ((u_) >> 9) * 8192; } else { N2_ = 128; lg2_ = 7; tokbase_ = T_P + (((u_) - 4096) >> 9) * 16384; } \
        const int rem_ = (u_) & 511; ka_ = rem_ >> 2; cblk_ = rem_ & 3; } while (0)
#define F2_LOAD(u_, V) do { int N2_, lg2_, tb_, ka_, cblk_; F2_DECODE(u_, N2_, lg2_, tb_, ka_, cblk_); \
        _Pragma("unroll") for (int j = 0; j < 4; ++j) { const int item = tid + 512 * j; if (item < N2_ * 16) { const int b = item & (N2_ - 1), rest = item >> lg2_, part = rest >> 3, ch8 = rest & 7; \
            V[j] = *(const u32x4*)(Y1 + (size_t)(tb_ + ka_ * N2_ + b) * 512 + part * 256 + cblk_ * 64 + ch8 * 8); } } } while (0)
    u32x4 nx[4];
#pragma unroll
    for (int j = 0; j < 4; ++j) nx[j] = (u32x4){0u, 0u, 0u, 0u};
    if ((int)blockIdx.x < 5120) F2_LOAD((int)blockIdx.x, nx);
    for (int u = blockIdx.x; u < 5120; u += gridDim.x) {
        int N2, lg2, tokbase, ka, cblk; F2_DECODE(u, N2, lg2, tokbase, ka, cblk);
        const bf16_t* D2 = (N2 == 128) ? (const bf16_t*)(p.ws + WS_DFT2B) : (const bf16_t*)(p.ws + WS_DFT2A);
#pragma unroll
        for (int j = 0; j < 4; ++j) { const int item = tid + 512 * j; if (item < N2 * 16) { const int b = item & (N2 - 1), rest = item >> lg2, part = rest >> 3, ch8 = rest & 7;
            const u32x4 v = nx[j];
#pragma unroll
            for (int e = 0; e < 8; ++e) BT[(ch8 * 8 + e) * PITCH + part * N2 + b] = (bf16_t)((e & 1) ? (v[e >> 1] >> 16) : (v[e >> 1] & 0xffffu)); } }
        __syncthreads();
        if (u + (int)gridDim.x < 5120) F2_LOAD(u + (int)gridDim.x, nx);
        const int nb = (N2 == 128) ? wave : (wave & 3), mt0 = (N2 == 128) ? 0 : 2 * (wave >> 2), nmt = (N2 == 128) ? 4 : 2, ksteps = N2 >> 4, K2 = 2 * N2;
        f32x4 acc[4];
#pragma unroll
        for (int i = 0; i < 4; ++i) acc[i] = (f32x4){0.f, 0.f, 0.f, 0.f};
        for (int kk = 0; kk < ksteps; ++kk) { const bf16x8 df = *(const bf16x8*)(D2 + (size_t)(nb * 16 + fr) * K2 + kk * 32 + fq * 8);
#pragma unroll
            for (int i = 0; i < 4; ++i) if (i < nmt) { const bf16x8 bfr = *(const bf16x8*)(BT + ((mt0 + i) * 16 + fr) * PITCH + kk * 32 + fq * 8);
                acc[i] = __builtin_amdgcn_mfma_f32_16x16x32_bf16(bfr, df, acc[i], 0, 0, 0); } }
        const float scale = (N2 == 128) ? 9.765625e-4f : 1.3810679e-3f;
        const int kb = nb * 16 + fr;
        bf16_t* up = U + (size_t)(tokbase + ka + 128 * kb) * 1024 + 768 + cblk * 64 + 4 * fq;
#pragma unroll
        for (int i = 0; i < 4; ++i) if (i < nmt) { const f32x4 y = acc[i] * scale; u32x2 o; o.x = pk2(y[0], y[1]); o.y = pk2(y[2], y[3]); *(u32x2*)(up + (mt0 + i) * 16) = o; }
        __syncthreads();
    }
#undef F2_LOAD
#undef F2_DECODE
}

#define XB_TMO      128
#define XB_XCNT(j)  (256  + 64 * (j))
#define XB_XSUB(j)  (1280 + 64 * (j))
#define XB_XGEN(j)  (2304 + 64 * (j))
#define XB_TOP      3328
#define XB_TOPGEN   3392
#define XCD_BAR_WORDS 3456
#define XB_SPIN_CAP (1u << 22)
__device__ __forceinline__ unsigned xb_ld(unsigned* p)              { return __hip_atomic_load(p, __ATOMIC_RELAXED, __HIP_MEMORY_SCOPE_AGENT); }
__device__ __forceinline__ unsigned xb_add(unsigned* p, unsigned v) { return __hip_atomic_fetch_add(p, v, __ATOMIC_RELAXED, __HIP_MEMORY_SCOPE_AGENT); }
__device__ __forceinline__ unsigned xb_xcc_id() { return (unsigned)__builtin_amdgcn_s_getreg((3 << 11) | 20) & 0xFu; }
#define XB_SPIN(cond, bar) do { unsigned _sp = 0; while (cond) { __builtin_amdgcn_s_sleep(1); \
    if ((++_sp & 255u) == 0u) { if (xb_ld(&(bar)[XB_TMO])) break; if (_sp > XB_SPIN_CAP) { atomicAdd(&(bar)[XB_TMO], 1u); break; } } } } while (0)
struct XcdBarrier { unsigned* bar; unsigned x; volatile LAS unsigned* st; };
__device__ __forceinline__ XcdBarrier xcd_barrier_post(unsigned* bar, volatile LAS unsigned* st) {
    XcdBarrier b; b.bar = bar; b.x = xb_xcc_id(); b.st = st;
    if (threadIdx.x == 0) (void)xb_add(&bar[XB_XCNT(b.x)], 1u);
    return b;
}
__device__ __forceinline__ void xcd_barrier_complete(unsigned* bar, unsigned x, unsigned& nloc, unsigned& nx) {
    const unsigned G = gridDim.x * gridDim.y * gridDim.z;
    unsigned sum, cnt, mine, sp = 0u;
    for (;;) {
        sum = 0u; cnt = 0u; mine = 0u;
#pragma unroll
        for (unsigned j = 0; j < 16; ++j) { const unsigned c = xb_ld(&bar[XB_XCNT(j)]); sum += c; cnt += (c > 0u) ? 1u : 0u; mine = (j == x) ? c : mine; }
        if (sum == G) break;
        __builtin_amdgcn_s_sleep(1);
        if ((++sp & 255u) == 0u) { if (xb_ld(&bar[XB_TMO])) break; if (sp > XB_SPIN_CAP) { atomicAdd(&bar[XB_TMO], 1u); break; } }
    }
    nloc = mine > 0u ? mine : 1u; nx = cnt > 0u ? cnt : 1u;
}
__device__ __forceinline__ void xcd_barrier(const XcdBarrier& b) {
    asm volatile("s_waitcnt vmcnt(0)" ::: "memory");
    __syncthreads();
    if (threadIdx.x == 0) {
        unsigned* bar = b.bar;
        __builtin_amdgcn_s_waitcnt(0);
        unsigned nloc = b.st[0], nx = b.st[1];
        if (nloc == 0u) { xcd_barrier_complete(bar, b.x, nloc, nx); b.st[0] = nloc; b.st[1] = nx; }
        const unsigned old = xb_add(&bar[XB_XSUB(b.x)], 1u);
        const unsigned gen = old / nloc;
        if (old + 1u == (gen + 1u) * nloc) {
            __builtin_amdgcn_fence(__ATOMIC_RELEASE, "agent");
            asm volatile("s_waitcnt vmcnt(0)" ::: "memory");
            const unsigned og = xb_add(&bar[XB_TOP], 1u);
            const unsigned tg = og / nx;
            if (og + 1u == (tg + 1u) * nx) xb_add(&bar[XB_TOPGEN], 1u);
            else XB_SPIN(xb_ld(&bar[XB_TOPGEN]) == tg, bar);
            __builtin_amdgcn_fence(__ATOMIC_ACQUIRE, "agent");
            xb_add(&bar[XB_XGEN(b.x)], 1u);
            asm volatile("s_waitcnt vmcnt(0)" ::: "memory");
        } else {
            XB_SPIN(xb_ld(&bar[XB_XGEN(b.x)]) == gen, bar);
            __builtin_amdgcn_fence(__ATOMIC_ACQUIRE, "agent");
            asm volatile("s_waitcnt vmcnt(0)" ::: "memory");
        }
    }
    __syncthreads();
}

__device__ __forceinline__ int opaque(int v) { int r; asm volatile("s_mov_b32 %0, %1" : "=s"(r) : "s"(v)); return r; }
__global__ void __launch_bounds__(512, 2) fwd_mega(Params p) {
    extern __shared__ __attribute__((aligned(16))) unsigned char smem[];
    cg::grid_group grid = cg::this_grid();
    LAS unsigned char* lds = (LAS unsigned char*)smem;
    unsigned char* ws = p.ws;
    const int lo = p.ph_lo, hi = p.ph_hi, G = gridDim.x, bid = blockIdx.x;
    const float* mod = (const float*)(ws + WS_MOD);
    bf16_t* H = (bf16_t*)(ws + WS_H);
    bf16_t* P = (bf16_t*)(ws + WS_P);
    float* out = p.out;
    bf16_t* U = (bf16_t*)((unsigned char*)p.out + DO_U);
    bf16_t* X = H;
    float* rowpart = (float*)(ws + WS_RP);
    const float* biasb = (const float*)(ws + WS_BIAS);
    bool first = true;
    volatile LAS unsigned* xst = (volatile LAS unsigned*)(lds + 131072);
    if (threadIdx.x == 0) { xst[0] = 0u; xst[1] = 0u; }
    __syncthreads();
    XcdBarrier xbar = xcd_barrier_post((unsigned*)(ws + WS_BAR), xst);
    int nseam = 0;
#if PROBE_SYNCS
    for (int i = 0; i < PROBE_SYNCS; ++i) grid.sync();
#endif
#pragma unroll 1
    for (int ph = lo; ph < hi; ++ph) {
        if (ph == 5 || ph == 8 || ph == 13) continue;
#if PROBE_MASK
        for (int rep = 0; rep < (((PROBE_MASK >> ph) & 1) ? 2 : 1); ++rep) {
#endif
        if (!first) { if (hi > 1000) grid.sync(); else xcd_barrier(xbar); ++nseam; }
        first = false;
        const int l = ph >= 8 ? 1 : 0;
        const float* modl = mod + (size_t)l * 61440;
        if (ph == 0) phase_prep(p, smem);
        else if (ph == 1) { phase_wscaled(p, smem); phase_bias(p, smem); phase_norm(p.in[0], p.in[1], mod, 1, 0, H); }
        else if (ph == 2) { pg8::Gemm g{H, (const bf16_t*)(ws + WS_WAB_IN), T_TOK, opaque(2560), opaque(1024), 0}; pg8::StaticOrder S; S.init(T_TOK, g.N, G, bid);
            EpiAct<0> E{P, 1536, nullptr, nullptr, 0}; pg8::gemm_phase<EpiAct<0>, pg8::StaticOrder>(lds, g, S, E); }
#if PROBE_HOT
        else if (ph == 3) { { struct HotOrder : pg8::StaticOrder { __device__ bool next(int i, Unit& u) const { if (!pg8::StaticOrder::next(i, u)) return false; u.pm = 0; u.pn = u.pn % PROBE_HOT; return true; } };
            pg8::Gemm g{H, (const bf16_t*)(ws + WS_WAB_IN), T_TOK, opaque(2560), opaque(1024), 0}; HotOrder S; S.init(T_TOK, g.N, G, bid);
            EpiAct<2> E{(bf16_t*)(ws + WS_END), 2560, nullptr, nullptr, 0}; pg8::gemm_phase<EpiAct<2>, HotOrder>(lds, g, S, E); }
            grid.sync(); phase_conv(p, smem); }
#else
        else if (ph == 3) phase_conv(p, smem);
#endif
        else if (ph == 4) { pg8::Gemm g{U, (const bf16_t*)(ws + WS_WAB_OUT), T_TOK, opaque(1024), opaque(1024), 0}; pg8::StaticOrder S; S.init(T_TOK, g.N, G, bid);
            EpiRes<true> E{p.in[0], p.in[1], X, mod + 2 * 1024, rowpart}; pg8::gemm_phase<EpiRes<true>, pg8::StaticOrder>(lds, g, S, E); }
        else if (ph == 7 || ph == 12 || ph == 15) {
            const bool ffn = (ph != 12);
            const bf16_t* A = ffn ? P : U;
            const bf16_t* Bt = ph == 12 ? (const bf16_t*)(ws + WS_WCD_OUT) : (const bf16_t*)(ws + WS_WFFN_OUT) + (size_t)l * 1024 * 2816;
            pg8::Gemm g{A, Bt, T_TOK, opaque(1024), opaque(ffn ? DFF : 1024), 0}; pg8::StaticOrder S; S.init(T_TOK, g.N, G, bid);
            const int ri = ph == 7 ? 1 : ph == 12 ? 2 : 3;
            EpiRes<false> E{nullptr, nullptr, X, modl + (ffn ? 5 : 2) * 1024, rowpart + (size_t)ri * T_TOK * 16};
            pg8::gemm_phase<EpiRes<false>, pg8::StaticOrder>(lds, g, S, E);
        }
        else if (ph == 6 || ph == 14) { const bf16_t* Bt = l == 0 ? (const bf16_t*)(ws + WS_WF0) : (const bf16_t*)((unsigned char*)p.out + DO_WF1);
            pg8::Gemm g{X, Bt, T_TOK, opaque(5632), opaque(1024), (size_t)5632 * 1024 * 2}; pg8::StaticOrder S; S.init(T_TOK, g.N, G, bid);
            EpiAct<1> E{P, DFF, rowpart + (size_t)(l == 0 ? 0 : 2) * T_TOK * 16, biasb + (l == 0 ? 0 : 56320 + 20480), 5632}; pg8::gemm_phase<EpiAct<1>, pg8::StaticOrder>(lds, g, S, E); }
        else if (ph == 9) { pg8::Gemm g{X, (const bf16_t*)((unsigned char*)p.out + DO_WCD), T_TOK, opaque(2048), opaque(1024), (size_t)2048 * 1024 * 2}; pg8::StaticOrder S; S.init(T_TOK, g.N, G, bid);
            EpiAct<2> E{P, 2048, rowpart + (size_t)1 * T_TOK * 16, biasb + 56320, 2048}; pg8::gemm_phase<EpiAct<2>, pg8::StaticOrder>(lds, g, S, E); }
#if PROBE_SG
        else if (ph == 10) { phase_sg(p, smem); __syncthreads(); phase_sg(p, smem); __syncthreads(); phase_fft1(p, smem); }
#else
        else if (ph == 10) { phase_sg(p, smem); __syncthreads(); phase_fft1(p, smem); }
#endif
        else if (ph == 11) phase_fft2(p, smem);
        else if (ph == 16) phase_final(out, X, rowpart + (size_t)3 * T_TOK * 16, p.in[23]);
#if PROBE_MASK
        }
#endif
    }
}

#ifndef N_LAUNCH_SPLIT
#define N_LAUNCH_SPLIT 0
#endif
extern "C" void kernel_launch(void* const* d_in, const int* in_sizes, int n_in, void* d_out, int out_size, void* d_ws, size_t ws_size, hipStream_t stream) {
    static int grid = 0;
    if (grid == 0) {
        if (n_in != 24 || ws_size < WS_END) { fprintf(stderr, "kernel_launch: unexpected n_in %d or ws_size %zu (need %zu)\n", n_in, ws_size, (size_t)WS_END); grid = -1; return; }
        int dev = 0, cus = 0, per_cu = 0;
        hipGetDevice(&dev);
        hipDeviceGetAttribute(&cus, hipDeviceAttributeMultiprocessorCount, dev);
        if (hipFuncSetAttribute((const void*)fwd_mega, hipFuncAttributeMaxDynamicSharedMemorySize, LDS_BYTES) != hipSuccess) { fprintf(stderr, "kernel_launch: hipFuncSetAttribute failed\n"); grid = -1; return; }
        if (hipOccupancyMaxActiveBlocksPerMultiprocessor(&per_cu, (const void*)fwd_mega, 512, LDS_BYTES) != hipSuccess || per_cu < 1) { fprintf(stderr, "kernel_launch: occupancy query says %d\n", per_cu); per_cu = 1; }
        (void)hipGetLastError();
        grid = cus;
        if (grid > 256) grid = 256;
    }
    if (grid < 0) return;
    Params p{};
    for (int i = 0; i < 24; ++i) p.in[i] = (const float*)d_in[i];
    p.out = (float*)d_out; p.ws = (unsigned char*)d_ws;
#if N_LAUNCH_SPLIT
    for (int ph = 0; ph < 17; ++ph) { p.ph_lo = ph; p.ph_hi = ph + 1; void* args[] = {&p};
        hipError_t e = hipLaunchCooperativeKernel((const void*)fwd_mega, dim3(grid), dim3(512), args, LDS_BYTES, stream);
        if (e != hipSuccess) { fprintf(stderr, "cooperative launch failed: %s (grid %d)\n", hipGetErrorString(e), grid); break; } }
#else
    if (hipMemsetAsync((char*)d_ws + WS_BAR, 0, 16384, stream) != hipSuccess) { fprintf(stderr, "kernel_launch: memset of barrier words failed\n"); return; }
    p.ph_lo = 0; p.ph_hi = 17; void* args[] = {&p};
    hipError_t e = hipLaunchCooperativeKernel((const void*)fwd_mega, dim3(grid), dim3(512), args, LDS_BYTES, stream);
    if (e != hipSuccess) fprintf(stderr, "cooperative launch failed: %s (grid %d)\n", hipGetErrorString(e), grid);
#endif
}
```

```cpp
#include <hip/hip_runtime.h>
#include <hip/hip_cooperative_groups.h>
#include <cstdio>
namespace cg = cooperative_groups;

namespace pg8 {
#define PG8_LAS __attribute__((address_space(3)))
typedef unsigned short bf16_t;
typedef short bf16x8 __attribute__((ext_vector_type(8)));
typedef float f32x4 __attribute__((ext_vector_type(4)));
typedef unsigned u32x4 __attribute__((ext_vector_type(4)));
constexpr int BM = 256, BK = 64, HALF = 128, HTB = HALF * BK * 2  , STAGE_BYTES = 8 * HTB, NXCD = 8, WGM = 8;

__host__ __device__ __forceinline__ int lds_byte(int r, int c) { const int st = (r >> 4) * 2 + (c >> 5), rr = r & 15, cc = c & 31, ob = rr * 64 + cc * 2; return st * 1024 + (ob ^ (((ob >> 9) & 1) << 5)); }
__host__ __device__ __forceinline__ void stage_rc(int b, int& R, int& C) { const int st = b / 1024, sb = b % 1024, swz = sb ^ (((sb >> 9) & 1) << 5); R = (st >> 1) * 16 + swz / 64; C = (st & 1) * 32 + (swz % 64) / 2; }
__host__ __device__ __forceinline__ int perm32(int rho) { const int n = rho >> 4, i = rho & 15; return 8 * (i >> 2) + 4 * n + (i & 3); }

struct Unit { int pm, pn; };
struct Gemm { const bf16_t* A; const bf16_t* Bt; int M, N, K; size_t bseq; };
__device__ __forceinline__ int seq_of_pm(int pm) { return pm < 256 ? (pm >> 5) : 8 + ((pm - 256) >> 6); }

struct StaticOrder {
    int nM, nN, nwg, G, c;
    __host__ __device__ void init(int M, int N, int G_, int c_) { nM = M / BM; nN = N / BM; nwg = nM * nN; G = G_; c = c_; }
    __host__ __device__ bool next(int i, Unit& u) const {
        const long L = (long)i * G + c; if (L >= nwg) return false;
        int wgid = (int)L; { const int q = nwg / NXCD, r = nwg % NXCD, xcd = wgid % NXCD, off = wgid / NXCD; wgid = (xcd < r ? xcd * (q + 1) : r * (q + 1) + (xcd - r) * q) + off; }
        const int nig = WGM * nN, gid = wgid / nig, fm = gid * WGM, gsz = (nM - fm) < WGM ? (nM - fm) : WGM;
        u.pm = fm + ((wgid % nig) % gsz); u.pn = (wgid % nig) / gsz; return true;
    }
    __device__ __forceinline__ void a_ready(const Unit&) const {}
    __device__ __forceinline__ void done(const Unit&) const {}
};
__device__ __forceinline__ unsigned cvt_pk_bf16(float lo, float hi) { unsigned r; asm volatile("v_cvt_pk_bf16_f32 %0, %1, %2" : "=v"(r) : "v"(lo), "v"(hi)); return r; }
template <class Epi, class Sched>
__device__ __forceinline__ void gemm_phase(PG8_LAS unsigned char* lds, const Gemm g, const Sched& S, const Epi& E) {
    int tid = threadIdx.x; asm volatile("" : "+v"(tid)); const int wid = __builtin_amdgcn_readfirstlane(tid >> 6), lane = tid & 63, wr = wid >> 2, wc = wid & 3, fr = lane & 15, fq = lane >> 4;
    const int K = g.K, nt = K / BK;
    unsigned voffA[2], voffB[2];
#pragma unroll
    for (int i = 0; i < 2; ++i) { int R, C; stage_rc(tid * 16 + i * 8192, R, C); const int Rb = Epi::PERM ? ((R & ~31) + perm32(R & 31)) : R;
        voffA[i] = (unsigned)(R * K + C) * 2u; voffB[i] = (unsigned)(Rb * K + C) * 2u; }
    const size_t kstep = (size_t)(BK * 2);
    const size_t hstep = (size_t)HALF * K * 2;
    const size_t tstep = 2 * hstep;
    const unsigned ldsw = (unsigned)wid * 1024u;
    const int aoff = lds_byte(wr * 64 + fr, fq * 8), boff = lds_byte(wc * 32 + fr, fq * 8);
#define PG8_SA(b, h) (((b) * 2 + (h)) * HTB)
#define PG8_SB(b, h) ((4 + (b) * 2 + (h)) * HTB)
#define PG8_STAGE(bufoff, gbase, voff, AUX) do { _Pragma("unroll") for (int _i = 0; _i < 2; ++_i) \
        __builtin_amdgcn_global_load_lds((const unsigned*)((const char*)(gbase) + (voff)[_i]), (PG8_LAS unsigned*)(lds + (bufoff) + ldsw + _i * 8192), 16, 0, AUX); } while (0)
#define PG8_LDA(dst, b, h) do { _Pragma("unroll") for (int m = 0; m < 4; ++m) _Pragma("unroll") for (int k = 0; k < 2; ++k) dst[m][k] = *(const PG8_LAS bf16x8*)(lds + PG8_SA(b, h) + aoff + m * 2048 + k * 1024); } while (0)
#define PG8_LDB(dst, b, h) do { _Pragma("unroll") for (int n = 0; n < 2; ++n) _Pragma("unroll") for (int k = 0; k < 2; ++k) dst[n][k] = *(const PG8_LAS bf16x8*)(lds + PG8_SB(b, h) + boff + n * 2048 + k * 1024); } while (0)
#define PG8_MMA(ai, bj, At, Bt) do { __builtin_amdgcn_s_setprio(1); _Pragma("unroll") for (int m = 0; m < 4; ++m) _Pragma("unroll") for (int n = 0; n < 2; ++n) _Pragma("unroll") for (int k = 0; k < 2; ++k) \
        acc[ai][bj][m][n] = __builtin_amdgcn_mfma_f32_16x16x32_bf16(Bt[n][k], At[m][k], acc[ai][bj][m][n], 0, 0, 0); __builtin_amdgcn_s_setprio(0); } while (0)
#define PG8_WAIT_V(n) asm volatile("s_waitcnt vmcnt(" #n ")" ::: "memory")
#define PG8_WAIT_L(n) asm volatile("s_waitcnt lgkmcnt(" #n ")" ::: "memory")
#define PG8_BAR __builtin_amdgcn_s_barrier()
#define PG8_SCHED __builtin_amdgcn_sched_barrier(0)
    Unit cur, nxt; int ui = 0;
    if (!S.next(0, cur)) return;
    f32x4 acc[2][2][4][2];
#pragma unroll
    for (int a = 0; a < 2; ++a)
#pragma unroll
        for (int b = 0; b < 2; ++b)
#pragma unroll
            for (int m = 0; m < 4; ++m)
#pragma unroll
                for (int n = 0; n < 2; ++n) acc[a][b][m][n] = (f32x4){0.f, 0.f, 0.f, 0.f};
    bf16x8 At[4][2], B0[2][2], B1[2][2];
    const char* cA = (const char*)g.A + (size_t)cur.pm * tstep; const char* cB = (const char*)g.Bt + (size_t)cur.pn * tstep + (size_t)seq_of_pm(cur.pm) * g.bseq;
    S.a_ready(cur);
    PG8_STAGE(PG8_SB(0, 0), cB, voffB, Epi::B_AUX); PG8_STAGE(PG8_SA(0, 0), cA, voffA, Epi::A_AUX); PG8_STAGE(PG8_SB(0, 1), cB + hstep, voffB, Epi::B_AUX); PG8_STAGE(PG8_SA(0, 1), cA + hstep, voffA, Epi::A_AUX);
    if (wr == 1) PG8_BAR;
    PG8_WAIT_V(4); PG8_BAR;
    PG8_STAGE(PG8_SB(1, 0), cB + kstep, voffB, Epi::B_AUX); PG8_STAGE(PG8_SA(1, 0), cA + kstep, voffA, Epi::A_AUX); PG8_STAGE(PG8_SB(1, 1), cB + hstep + kstep, voffB, Epi::B_AUX);
    PG8_STAGE(PG8_SA(1, 1), cA + hstep + kstep, voffA, Epi::A_AUX);
    PG8_WAIT_V(8); PG8_BAR;
    for (;;) {
        const bool has_next = S.next(ui + 1, nxt);
        const char* nA = has_next ? (const char*)g.A + (size_t)nxt.pm * tstep : cA; const char* nB = has_next ? (const char*)g.Bt + (size_t)nxt.pn * tstep + (size_t)seq_of_pm(nxt.pm) * g.bseq : cB;
        for (int t = 0; t < nt; t += 2) {
            const bool last = (t == nt - 2);
            const char* a2 = last ? nA : cA + (size_t)(t + 2) * kstep; const char* b2 = last ? nB : cB + (size_t)(t + 2) * kstep;
            const char* a3 = a2 + kstep; const char* b3 = b2 + kstep;
            if (last && has_next) S.a_ready(nxt);
            PG8_LDB(B0, 0, 0); PG8_SCHED; PG8_LDA(At, 0, 0);
            PG8_WAIT_L(8); PG8_BAR; PG8_WAIT_L(0); PG8_MMA(0, 0, At, B0); PG8_BAR; PG8_SCHED;
            PG8_LDB(B1, 0, 1); PG8_STAGE(PG8_SB(0, 0), b2, voffB, Epi::B_AUX);
            PG8_BAR; PG8_WAIT_L(0); PG8_MMA(0, 1, At, B1); PG8_BAR;
            PG8_LDA(At, 0, 1); PG8_STAGE(PG8_SA(0, 0), a2, voffA, Epi::A_AUX);
            PG8_BAR; PG8_WAIT_L(0); PG8_MMA(1, 0, At, B0); PG8_BAR; PG8_SCHED;
            PG8_STAGE(PG8_SB(0, 1), b2 + hstep, voffB, Epi::B_AUX);
            { const int relax = __builtin_amdgcn_readfirstlane((t == 0 && ui > 0) ? 1 : 0);
              asm volatile("s_cmp_eq_u32 %0, 0\n\ts_cbranch_scc1 .Lpg8w6_%=\n\ts_waitcnt vmcnt(%1)\n\ts_branch .Lpg8wd_%=\n.Lpg8w6_%=:\n\ts_waitcnt vmcnt(6)\n.Lpg8wd_%=:" :: "s"(relax), "n"(6 + Epi::TAIL_STORES) : "scc", "memory"); }
            PG8_BAR; PG8_MMA(1, 1, At, B1); PG8_BAR;
            PG8_LDB(B0, 1, 0); PG8_SCHED; PG8_LDA(At, 1, 0); PG8_STAGE(PG8_SA(0, 1), a2 + hstep, voffA, Epi::A_AUX);
            PG8_WAIT_L(8); PG8_BAR; PG8_WAIT_L(0); PG8_MMA(0, 0, At, B0); PG8_BAR; PG8_SCHED;
            PG8_LDB(B1, 1, 1); PG8_STAGE(PG8_SB(1, 0), b3, voffB, Epi::B_AUX);
            PG8_BAR; PG8_WAIT_L(0); PG8_MMA(0, 1, At, B1); PG8_BAR;
            PG8_LDA(At, 1, 1); PG8_STAGE(PG8_SA(1, 0), a3, voffA, Epi::A_AUX);
            PG8_BAR; PG8_WAIT_L(0); PG8_MMA(1, 0, At, B0); PG8_BAR; PG8_SCHED;
            PG8_STAGE(PG8_SB(1, 1), b3 + hstep, voffB, Epi::B_AUX);
            PG8_WAIT_V(6); PG8_BAR; PG8_MMA(1, 1, At, B1); PG8_BAR;
            PG8_STAGE(PG8_SA(1, 1), a3 + hstep, voffA, Epi::A_AUX);
        }
        if constexpr (!Epi::AFTER_DRAIN) { E(acc, cur, wr, wc, fr, fq); S.done(cur); }
        if (!has_next) break;
#pragma unroll
        for (int a = 0; a < 2; ++a)
#pragma unroll
            for (int b = 0; b < 2; ++b)
#pragma unroll
                for (int m = 0; m < 4; ++m)
#pragma unroll
                    for (int n = 0; n < 2; ++n) acc[a][b][m][n] = (f32x4){0.f, 0.f, 0.f, 0.f};
        cur = nxt; cA = nA; cB = nB; ++ui;
    }
    PG8_WAIT_V(0);
    if (wr == 0) PG8_BAR;
    PG8_BAR;
    if constexpr (Epi::AFTER_DRAIN) { E.fused(acc, cur, wr, wc, fr, fq, lds, wid, lane); S.done(cur); }
#undef PG8_SA
#undef PG8_SB
#undef PG8_STAGE
#undef PG8_LDA
#undef PG8_LDB
#undef PG8_MMA
#undef PG8_WAIT_V
#undef PG8_WAIT_L
#undef PG8_BAR
#undef PG8_SCHED
}
}


using pg8::bf16_t; using pg8::bf16x8; using pg8::f32x4; using pg8::u32x4; using pg8::Unit;
typedef unsigned u32x2 __attribute__((ext_vector_type(2)));
#define LAS PG8_LAS
constexpr int T_TOK = 98304, T_P = 65536, DM = 1024, DFF = 2816;
constexpr int LDS_BYTES = 131072 + 16;
constexpr float EPSV = 1e-6f;

constexpr size_t WS_WAB_IN = 0;
constexpr size_t WS_WAB_OUT = WS_WAB_IN + (size_t)2560 * 1024 * 2;
constexpr size_t WS_WCD_IN = WS_WAB_OUT + (size_t)1024 * 1024 * 2;
constexpr size_t WS_WCD_OUT = WS_WCD_IN + (size_t)2048 * 1024 * 2;
constexpr size_t WS_WFFN_IN = WS_WCD_OUT + (size_t)1024 * 1024 * 2;
constexpr size_t WS_WFFN_OUT = WS_WFFN_IN + (size_t)2 * 5632 * 1024 * 2;
constexpr size_t WS_WS = WS_WFFN_OUT + (size_t)2 * 1024 * 2816 * 2;
constexpr size_t WS_MOD = WS_WS + (size_t)6 * 128 * 128 * 2;
constexpr size_t WS_DFT1 = WS_MOD + (size_t)2 * 10 * 6144 * 4;
constexpr size_t WS_DFT2A = WS_DFT1 + (size_t)256 * 256 * 2;
constexpr size_t WS_DFT2B = WS_DFT2A + (size_t)64 * 128 * 2;
constexpr size_t WS_H = WS_DFT2B + (size_t)128 * 256 * 2;
constexpr size_t WS_P = WS_H + (size_t)T_TOK * 1024 * 2;
constexpr size_t WS_Y1 = WS_P + (size_t)T_TOK * 2048 * 2;
constexpr size_t WS_RP = WS_P + (size_t)T_TOK * 2816 * 2;
constexpr size_t WS_BIAS = WS_RP + (size_t)4 * T_TOK * 16 * 4;
constexpr size_t WS_WF0 = WS_BIAS + (size_t)10 * (5632 + 2048 + 5632) * 4;
constexpr size_t WS_BAR = WS_WF0 + (size_t)10 * 5632 * 1024 * 2;
constexpr size_t WS_END = WS_BAR + 16384;
constexpr size_t DO_U = 0;
constexpr size_t DO_WCD = DO_U + (size_t)T_TOK * 1024 * 2;
constexpr size_t DO_WF1 = DO_WCD + (size_t)10 * 2048 * 1024 * 2;
constexpr size_t DO_END = DO_WF1 + (size_t)10 * 5632 * 1024 * 2;
static_assert(DO_END <= (size_t)T_TOK * 1024 * 4, "d_out scratch overflow");

#ifndef PROBE_SYNCS
#define PROBE_SYNCS 0
#endif
#ifndef PROBE_SG
#define PROBE_SG 0
#endif
#ifndef PROBE_HOT
#define PROBE_HOT 0
#endif
#ifndef PROBE_MASK
#define PROBE_MASK 0
#endif
struct Params { const float* in[24]; float* out; unsigned char* ws; int ph_lo, ph_hi; };

__device__ __forceinline__ int tid_opaque() { int t = threadIdx.x; asm volatile("" : "+v"(t)); return t; }
__device__ __forceinline__ int seq_of(int row) { return row < T_P ? (row >> 13) : 8 + ((row - T_P) >> 14); }
__device__ __forceinline__ float bf2f(unsigned short b) { return __uint_as_float(((unsigned)b) << 16); }
__device__ __forceinline__ unsigned pk2(float lo, float hi) { return pg8::cvt_pk_bf16(lo, hi); }
__device__ __forceinline__ float sigm(float x) { return __builtin_amdgcn_rcpf(1.0f + __builtin_amdgcn_exp2f(-1.44269504f * x)); }
__device__ __forceinline__ float wave_sum(float v) {
#pragma unroll
    for (int o = 32; o >= 1; o >>= 1) v += __shfl_xor(v, o);
    return v;
}

template <int KIND> struct EpiAct {
    static constexpr bool PERM = true, AFTER_DRAIN = false; static constexpr int A_AUX = 0, B_AUX = 0;
    static constexpr int TAIL_STORES = (KIND == 2) ? 16 : 8;
    bf16_t* O; int ldc; const float* rowpart; const float* bias; int nbias;
    __device__ __forceinline__ void operator()(const f32x4 (&acc)[2][2][4][2], const Unit& u, int wr, int wc, int fr, int fq) const {
        asm volatile("" : "+v"(fr), "+v"(fq));
        const int row0 = u.pm * 256 + wr * 64 + fr;
        float rs[2][4]; f32x4 bv[2][2];
        if (rowpart) {
#pragma unroll
            for (int ai = 0; ai < 2; ++ai)
#pragma unroll
                for (int m = 0; m < 4; ++m) { const f32x4 pv = *(const f32x4*)(rowpart + (size_t)(row0 + ai * 128 + m * 16) * 16 + 4 * fq);
                    float ss = (pv[0] + pv[1]) + (pv[2] + pv[3]); ss += __shfl_xor(ss, 16); ss += __shfl_xor(ss, 32);
                    rs[ai][m] = __builtin_amdgcn_rsqf(ss * (1.0f / 1024.0f) + EPSV); }
            const float* bp = bias + (size_t)seq_of(u.pm * 256) * nbias + u.pn * 256 + wc * 32 + 8 * fq;
#pragma unroll
            for (int bj = 0; bj < 2; ++bj)
#pragma unroll
                for (int n = 0; n < 2; ++n) bv[bj][n] = *(const f32x4*)(bp + bj * 128 + 4 * n);
        } else {
#pragma unroll
            for (int ai = 0; ai < 2; ++ai)
#pragma unroll
                for (int m = 0; m < 4; ++m) rs[ai][m] = 1.0f;
#pragma unroll
            for (int bj = 0; bj < 2; ++bj)
#pragma unroll
                for (int n = 0; n < 2; ++n) bv[bj][n] = (f32x4){0.f, 0.f, 0.f, 0.f};
        }
        int mode, colbase;
        if (KIND == 2) { mode = 0; colbase = u.pn * 256; }
        else if (KIND == 1) { mode = 3; colbase = u.pn * 128; }
        else { if (u.pn < 2) { mode = 0; colbase = u.pn * 256; } else if (u.pn < 6) { mode = 1; colbase = 512 + (u.pn - 2) * 128; } else { mode = 2; colbase = 1024 + (u.pn - 6) * 128; } }
        const int col0 = colbase + wc * 32 + 8 * fq;
#pragma unroll
        for (int ai = 0; ai < 2; ++ai)
#pragma unroll
            for (int m = 0; m < 4; ++m) { bf16_t* rowp = O + (size_t)(row0 + ai * 128 + m * 16) * ldc + col0;
                const float sc = rs[ai][m];
                const f32x4 a0 = acc[ai][0][m][0] * sc + bv[0][0], a1 = acc[ai][0][m][1] * sc + bv[0][1], b0 = acc[ai][1][m][0] * sc + bv[1][0], b1 = acc[ai][1][m][1] * sc + bv[1][1];
                if (mode == 0) {
                    u32x4 w; w.x = pk2(a0[0], a0[1]); w.y = pk2(a0[2], a0[3]); w.z = pk2(a1[0], a1[1]); w.w = pk2(a1[2], a1[3]);
                    __builtin_nontemporal_store(w, (u32x4*)rowp);
                    w.x = pk2(b0[0], b0[1]); w.y = pk2(b0[2], b0[3]); w.z = pk2(b1[0], b1[1]); w.w = pk2(b1[2], b1[3]);
                    __builtin_nontemporal_store(w, (u32x4*)(rowp + 128));
                } else {
                    float r[8];
#pragma unroll
                    for (int j = 0; j < 4; ++j) {
                        if (mode == 1) { r[j] = a0[j] * b0[j]; r[4 + j] = a1[j] * b1[j]; }
                        else if (mode == 2) { r[j] = a0[j] * sigm(b0[j]); r[4 + j] = a1[j] * sigm(b1[j]); }
                        else { r[j] = a0[j] * sigm(a0[j]) * b0[j]; r[4 + j] = a1[j] * sigm(a1[j]) * b1[j]; } }
                    u32x4 w; w.x = pk2(r[0], r[1]); w.y = pk2(r[2], r[3]); w.z = pk2(r[4], r[5]); w.w = pk2(r[6], r[7]);
                    __builtin_nontemporal_store(w, (u32x4*)rowp); }
            }
    }
};
#ifndef RES_A_AUX
#define RES_A_AUX 0
#endif
template <bool SRC_F32> struct EpiRes {
    static constexpr int TAIL_STORES = 8;
    static constexpr bool PERM = true, AFTER_DRAIN = false; static constexpr int A_AUX = RES_A_AUX, B_AUX = 0;
    const float* src0; const float* src1; bf16_t* X; const float* gate; float* rowpart;
    __device__ __forceinline__ void operator()(const f32x4 (&acc)[2][2][4][2], const Unit& u, int wr, int wc, int fr, int fq) const {
        asm volatile("" : "+v"(fr), "+v"(fq));
        const int rowl = wr * 64 + fr, col0 = u.pn * 256 + wc * 32 + 8 * fq, rbase = u.pm * 256;
        const int seq = seq_of(rbase);
        const float* gp = gate + (size_t)seq * 6144 + col0;
        f32x4 gv[2][2];
#pragma unroll
        for (int bj = 0; bj < 2; ++bj)
#pragma unroll
            for (int n = 0; n < 2; ++n) gv[bj][n] = *(const f32x4*)(gp + bj * 128 + 4 * n);
        bf16_t* xb = X + (size_t)rbase * 1024 + col0;
        const float* sb = (rbase < T_P) ? src0 + (size_t)rbase * 1024 + col0 : src1 + (size_t)(rbase - T_P) * 1024 + col0;
#pragma unroll
        for (int ai = 0; ai < 2; ++ai) {
            f32x4 sv[4][2][2];
            if (SRC_F32) {
#pragma unroll
                for (int m = 0; m < 4; ++m)
#pragma unroll
                    for (int bj = 0; bj < 2; ++bj)
#pragma unroll
                        for (int n = 0; n < 2; ++n) sv[m][bj][n] = *(const f32x4*)(sb + (size_t)(rowl + ai * 128 + m * 16) * 1024 + bj * 128 + 4 * n);
            } else {
                u32x4 raw[4][2];
#pragma unroll
                for (int m = 0; m < 4; ++m)
#pragma unroll
                    for (int bj = 0; bj < 2; ++bj) raw[m][bj] = *(const u32x4*)(xb + (size_t)(rowl + ai * 128 + m * 16) * 1024 + bj * 128);
#pragma unroll
                for (int m = 0; m < 4; ++m)
#pragma unroll
                    for (int bj = 0; bj < 2; ++bj) { const u32x4 r = raw[m][bj];
                        sv[m][bj][0] = (f32x4){__uint_as_float(r.x << 16), __uint_as_float(r.x & 0xffff0000u), __uint_as_float(r.y << 16), __uint_as_float(r.y & 0xffff0000u)};
                        sv[m][bj][1] = (f32x4){__uint_as_float(r.z << 16), __uint_as_float(r.z & 0xffff0000u), __uint_as_float(r.w << 16), __uint_as_float(r.w & 0xffff0000u)}; }
            }
#pragma unroll
            for (int m = 0; m < 4; ++m) { const int rl = rowl + ai * 128 + m * 16; float ss = 0.f;
#pragma unroll
                for (int bj = 0; bj < 2; ++bj) { const f32x4 x0 = sv[m][bj][0] + gv[bj][0] * acc[ai][bj][m][0], x1 = sv[m][bj][1] + gv[bj][1] * acc[ai][bj][m][1];
                    ss += (x0[0] * x0[0] + x0[1] * x0[1]) + (x0[2] * x0[2] + x0[3] * x0[3]) + (x1[0] * x1[0] + x1[1] * x1[1]) + (x1[2] * x1[2] + x1[3] * x1[3]);
                    u32x4 w; w.x = pk2(x0[0], x0[1]); w.y = pk2(x0[2], x0[3]); w.z = pk2(x1[0], x1[1]); w.w = pk2(x1[2], x1[3]);
                    *(u32x4*)(xb + (size_t)rl * 1024 + bj * 128) = w; }
                ss += __shfl_xor(ss, 16); ss += __shfl_xor(ss, 32);
                if (fq == 0) rowpart[(size_t)(rbase + rl) * 16 + u.pn * 4 + wc] = ss; }
            asm volatile("" ::: "memory");
        }
    }
};

__device__ __forceinline__ int map_ab(int n0) {
    if (n0 < 512) return n0;
    if (n0 < 1536) { const int q = (n0 - 512) >> 8, r = (n0 - 512) & 255; return r < 128 ? 512 + 128 * q + r : 1024 + 128 * q + (r - 128); }
    const int q = (n0 - 1536) >> 8, r = (n0 - 1536) & 255; return r < 128 ? 1536 + 128 * q + r : 2048 + 128 * q + (r - 128);
}
__device__ __forceinline__ int map_ffn(int n0) { const int q = n0 >> 8, r = n0 & 255; return r < 128 ? 128 * q + r : 2816 + 128 * q + (r - 128); }

__device__ __forceinline__ void tile_load(const float* __restrict__ src, int ld, int c0, int k0, float* tile) {
    const int tid = tid_opaque();
#pragma unroll
    for (int p = 0; p < 2; ++p) { const int r = (tid >> 4) + p * 32, c4 = (tid & 15) * 4;
        const f32x4 v = *(const f32x4*)(src + (size_t)(k0 + r) * ld + c0 + c4);
        float* t = tile + r * 65 + c4; t[0] = v[0]; t[1] = v[1]; t[2] = v[2]; t[3] = v[3]; }
}
__device__ __forceinline__ void tile_store_t(const float* tile, bf16_t* __restrict__ dst, int ldd, int n0, int k0) {
    const int tid = tid_opaque(), n = tid >> 3, k8 = (tid & 7) * 8;
    float f[8];
#pragma unroll
    for (int i = 0; i < 8; ++i) f[i] = tile[(k8 + i) * 65 + n];
    u32x4 w; w.x = pk2(f[0], f[1]); w.y = pk2(f[2], f[3]); w.z = pk2(f[4], f[5]); w.w = pk2(f[6], f[7]);
    *(u32x4*)(dst + (size_t)(n0 + n) * ldd + k0 + k8) = w;
}

__device__ void phase_prep(const Params& p, unsigned char* smem) {
    const int tid = tid_opaque(), lane = tid & 63, wave = tid >> 6, G = gridDim.x, bid = blockIdx.x;
    unsigned char* ws = p.ws;
    {
        float* sc = (float*)smem;
        float* red = sc + 10240;
        bool have = false;
        for (int task = bid; task < 192; task += G) {
            if (!have) { for (int i = tid; i < 10240; i += 512) { const float c = i < 8192 ? p.in[2][i] : p.in[3][i - 8192]; sc[i] = c * sigm(c); } have = true; }
            __syncthreads();
            const int l = task / 96, cb = task % 96, j = cb * 64 + lane;
            const float* W = p.in[4] + (size_t)l * 1024 * 6144 + j;
            float acc[10];
#pragma unroll
            for (int s = 0; s < 10; ++s) acc[s] = 0.f;
            const int kbeg = wave * 128;
#pragma unroll 8
            for (int k = 0; k < 128; ++k) { const float w = W[(size_t)(kbeg + k) * 6144];
#pragma unroll
                for (int s = 0; s < 10; ++s) acc[s] = fmaf(sc[s * 1024 + kbeg + k], w, acc[s]); }
#pragma unroll
            for (int s = 0; s < 10; ++s) red[(wave * 10 + s) * 64 + lane] = acc[s];
            __syncthreads();
            for (int i = tid; i < 640; i += 512) { const int s = i >> 6, ln = i & 63; float v = 0.f;
#pragma unroll
                for (int w = 0; w < 8; ++w) v += red[(w * 10 + s) * 64 + ln];
                const int jj = cb * 64 + ln; v += p.in[5][l * 6144 + jj];
                const int chunk = jj >> 10, d = jj & 1023;
                if (chunk == 1) v = p.in[6][l * 1024 + d] * (1.0f + v); else if (chunk == 4) v = p.in[7][l * 1024 + d] * (1.0f + v);
                ((float*)(ws + WS_MOD))[(size_t)(l * 10 + s) * 6144 + jj] = v; }
            __syncthreads();
        }
        __syncthreads();
    }
    {
        const int gt = bid * 512 + tid, gn = G * 512;
        bf16_t* wsb = (bf16_t*)(ws + WS_WS);
        for (int i = gt; i < 6 * 128 * 128 / 2; i += gn) ((unsigned*)wsb)[i] = pk2(p.in[18][2 * i], p.in[18][2 * i + 1]);
        bf16_t* d1 = (bf16_t*)(ws + WS_DFT1);
        for (int i = gt; i < 256 * 256 / 2; i += gn) { float v[2];
#pragma unroll
            for (int e = 0; e < 2; ++e) { const int idx = 2 * i + e, m = idx >> 8, k = idx & 255, po = m >> 7, ka = m & 127, pi = k >> 7, a = k & 127;
                const float rev = (float)((ka * a) & 127) * (1.0f / 128.0f); const float c = __builtin_amdgcn_cosf(rev), s = __builtin_amdgcn_sinf(rev);
                v[e] = po == 0 ? (pi == 0 ? c : -s) : (pi == 0 ? -s : -c); }
            ((unsigned*)d1)[i] = pk2(v[0], v[1]); }
        bf16_t* d2a = (bf16_t*)(ws + WS_DFT2A);
        for (int i = gt; i < 64 * 128 / 2; i += gn) { float v[2];
#pragma unroll
            for (int e = 0; e < 2; ++e) { const int idx = 2 * i + e, kb = idx >> 7, k = idx & 127, pi = k >> 6, b = k & 63;
                const float rev = (float)((kb * b) & 63) * (1.0f / 64.0f); v[e] = pi == 0 ? __builtin_amdgcn_cosf(rev) : __builtin_amdgcn_sinf(rev); }
            ((unsigned*)d2a)[i] = pk2(v[0], v[1]); }
        bf16_t* d2b = (bf16_t*)(ws + WS_DFT2B);
        for (int i = gt; i < 128 * 256 / 2; i += gn) { float v[2];
#pragma unroll
            for (int e = 0; e < 2; ++e) { const int idx = 2 * i + e, kb = idx >> 8, k = idx & 255, pi = k >> 7, b = k & 127;
                const float rev = (float)((kb * b) & 127) * (1.0f / 128.0f); v[e] = pi == 0 ? __builtin_amdgcn_cosf(rev) : __builtin_amdgcn_sinf(rev); }
            ((unsigned*)d2b)[i] = pk2(v[0], v[1]); }
    }
    {
        float* tile = (float*)smem;
        float* trig = tile + 64 * 65;
        if (tid < 64) { const float rev = (float)tid * (1.0f / 64.0f); trig[tid] = __builtin_amdgcn_cosf(rev); trig[64 + tid] = __builtin_amdgcn_sinf(rev); }
        __syncthreads();
        for (int id = bid; id < 5824; id += G) {
            const float* src; int ld, c0, k0, n0, ldd; bf16_t* dst; bool fold = false; int fg = 0;
            if (id < 640) { const int kt = id & 15, nt = id >> 4; src = p.in[8]; ld = 2560; k0 = kt * 64; n0 = nt * 64; c0 = map_ab(n0); dst = (bf16_t*)(ws + WS_WAB_IN); ldd = 1024; }
            else if (id < 896) { const int i2 = id - 640, kt = i2 & 15, nt = i2 >> 4; src = p.in[14]; ld = 1024; k0 = kt * 64; n0 = nt * 64; c0 = n0; dst = (bf16_t*)(ws + WS_WAB_OUT); ldd = 1024; }
            else if (id < 1280) { const int i2 = id - 896, kt = i2 & 15, nt = i2 >> 4; src = p.in[15]; ld = 1792; k0 = kt * 64; n0 = nt * 64; c0 = n0; dst = (bf16_t*)(ws + WS_WCD_IN); ldd = 1024; }
            else if (id < 1344) { const int i2 = id - 1280, kt = i2 & 15; fg = i2 >> 4; src = p.in[15]; ld = 1792; k0 = kt * 64; n0 = 0; c0 = 1536 + 64 * fg; dst = (bf16_t*)(ws + WS_WCD_IN); ldd = 1024; fold = true; }
            else if (id < 1600) { const int i2 = id - 1344, kt = i2 & 15, nt = i2 >> 4; src = p.in[20]; ld = 1024; k0 = kt * 64; n0 = nt * 64; c0 = n0; dst = (bf16_t*)(ws + WS_WCD_OUT); ldd = 1024; }
            else if (id < 4416) { const int i2 = id - 1600, l = i2 / 1408, i3 = i2 % 1408, kt = i3 & 15, nt = i3 >> 4; src = p.in[21] + (size_t)l * 1024 * 5632; ld = 5632; k0 = kt * 64; n0 = nt * 64; c0 = map_ffn(n0);
                dst = (bf16_t*)(ws + WS_WFFN_IN) + (size_t)l * 5632 * 1024; ldd = 1024; }
            else { const int i2 = id - 4416, l = i2 / 704, i3 = i2 % 704, kt = i3 % 44, nt = i3 / 44; src = p.in[22] + (size_t)l * 2816 * 1024; ld = 1024; k0 = kt * 64; n0 = nt * 64; c0 = n0;
                dst = (bf16_t*)(ws + WS_WFFN_OUT) + (size_t)l * 1024 * 2816; ldd = 2816; }
            tile_load(src, ld, c0, k0, tile);
            __syncthreads();
            if (!fold) tile_store_t(tile, dst, ldd, n0, k0);
            else {
                const int np = tid >> 2, part = np >> 6, k2 = np & 63, kq = tid & 3;
                const float* tr = trig + part * 64;
                float a[16];
#pragma unroll
                for (int i = 0; i < 16; ++i) a[i] = 0.f;
                for (int n2 = 0; n2 < 64; ++n2) { const float t = tr[(k2 * n2) & 63];
#pragma unroll
                    for (int i = 0; i < 16; ++i) a[i] = fmaf(tile[(kq * 16 + i) * 65 + n2], t, a[i]); }
                bf16_t* dp = dst + (size_t)(1536 + part * 256 + fg * 64 + k2) * 1024 + k0 + kq * 16;
                u32x4 w0, w1;
                w0.x = pk2(a[0], a[1]); w0.y = pk2(a[2], a[3]); w0.z = pk2(a[4], a[5]); w0.w = pk2(a[6], a[7]);
                w1.x = pk2(a[8], a[9]); w1.y = pk2(a[10], a[11]); w1.z = pk2(a[12], a[13]); w1.w = pk2(a[14], a[15]);
                *(u32x4*)dp = w0; *(u32x4*)(dp + 8) = w1;
            }
            __syncthreads();
        }
    }
}

__device__ void phase_norm(const float* src0, const float* src1, const float* modl, int chA, int chB, bf16_t* H) {
    const int tid = tid_opaque(), lane = tid & 63, wave = tid >> 6;
    const int nw = gridDim.x * 8;
    for (int row = blockIdx.x * 8 + wave; row < T_TOK; row += 2 * nw) {
        f32x4 v[2][4]; float ss[2];
#pragma unroll
        for (int r = 0; r < 2; ++r) { const int rr = (row + r * nw < T_TOK) ? row + r * nw : row;
            const float* xp = rr < T_P ? src0 + (size_t)rr * 1024 : src1 + (size_t)(rr - T_P) * 1024;
#pragma unroll
            for (int i = 0; i < 4; ++i) v[r][i] = *(const f32x4*)(xp + i * 256 + lane * 4); }
#pragma unroll
        for (int r = 0; r < 2; ++r) { float s = 0.f;
#pragma unroll
            for (int i = 0; i < 4; ++i) s += v[r][i][0] * v[r][i][0] + v[r][i][1] * v[r][i][1] + v[r][i][2] * v[r][i][2] + v[r][i][3] * v[r][i][3];
            ss[r] = wave_sum(s); }
#pragma unroll
        for (int r = 0; r < 2; ++r) { const int rr = row + r * nw; if (rr >= T_TOK) break;
            const float rstd = __builtin_amdgcn_rsqf(ss[r] * (1.0f / 1024.0f) + EPSV);
            const float* mp = modl + (size_t)seq_of(rr) * 6144;
#pragma unroll
            for (int i = 0; i < 4; ++i) { const f32x4 A = *(const f32x4*)(mp + chA * 1024 + i * 256 + lane * 4), B = *(const f32x4*)(mp + chB * 1024 + i * 256 + lane * 4);
                const f32x4 h = v[r][i] * rstd * A + B; u32x2 w; w.x = pk2(h[0], h[1]); w.y = pk2(h[2], h[3]);
                *(u32x2*)(H + (size_t)rr * 1024 + i * 256 + lane * 4) = w; } }
    }
}
__device__ void phase_final(float* out, const bf16_t* X, const float* rowpart, const float* g) {
    const int tid = tid_opaque(), lane = tid & 63, wave = tid >> 6;
    const int nw = gridDim.x * 8;
    f32x4 gv[4];
#pragma unroll
    for (int i = 0; i < 2; ++i) { gv[2 * i] = *(const f32x4*)(g + i * 512 + lane * 8); gv[2 * i + 1] = *(const f32x4*)(g + i * 512 + lane * 8 + 4); }
    for (int row = blockIdx.x * 8 + wave; row < T_TOK; row += 2 * nw) {
        u32x4 v[2][2]; f32x4 pp[2][4];
#pragma unroll
        for (int r = 0; r < 2; ++r) { const int rr = (row + r * nw < T_TOK) ? row + r * nw : row;
#pragma unroll
            for (int i = 0; i < 2; ++i) v[r][i] = *(const u32x4*)(X + (size_t)rr * 1024 + i * 512 + lane * 8);
#pragma unroll
            for (int i = 0; i < 4; ++i) pp[r][i] = *(const f32x4*)(rowpart + (size_t)rr * 16 + i * 4); }
#pragma unroll
        for (int r = 0; r < 2; ++r) { const int rr = row + r * nw; if (rr >= T_TOK) break;
            float ss = 0.f;
#pragma unroll
            for (int i = 0; i < 4; ++i) ss += (pp[r][i][0] + pp[r][i][1]) + (pp[r][i][2] + pp[r][i][3]);
            const float rstd = __builtin_amdgcn_rsqf(ss * (1.0f / 1024.0f) + EPSV);
            float* xp = out + (size_t)rr * 1024;
#pragma unroll
            for (int i = 0; i < 2; ++i) { const u32x4 q = v[r][i];
                const f32x4 a = (f32x4){__uint_as_float(q.x << 16), __uint_as_float(q.x & 0xffff0000u), __uint_as_float(q.y << 16), __uint_as_float(q.y & 0xffff0000u)};
                const f32x4 b = (f32x4){__uint_as_float(q.z << 16), __uint_as_float(q.z & 0xffff0000u), __uint_as_float(q.w << 16), __uint_as_float(q.w & 0xffff0000u)};
                *(f32x4*)(xp + i * 512 + lane * 8) = a * rstd * gv[2 * i]; *(f32x4*)(xp + i * 512 + lane * 8 + 4) = b * rstd * gv[2 * i + 1]; } }
    }
}
__device__ __forceinline__ void tile_store_scaled(const float* tile, bf16_t* __restrict__ dst, size_t seqstride, const float* __restrict__ avec, int n0, int k0) {
    const int tid = threadIdx.x, n = tid >> 3, k8 = (tid & 7) * 8;
    float f[8];
#pragma unroll
    for (int i = 0; i < 8; ++i) f[i] = tile[(k8 + i) * 65 + n];
#pragma unroll 2
    for (int sq = 0; sq < 10; ++sq) { const f32x4 a0 = *(const f32x4*)(avec + (size_t)sq * 6144 + k0 + k8), a1 = *(const f32x4*)(avec + (size_t)sq * 6144 + k0 + k8 + 4);
        u32x4 w; w.x = pk2(f[0] * a0[0], f[1] * a0[1]); w.y = pk2(f[2] * a0[2], f[3] * a0[3]); w.z = pk2(f[4] * a1[0], f[5] * a1[1]); w.w = pk2(f[6] * a1[2], f[7] * a1[3]);
        *(u32x4*)(dst + (size_t)sq * seqstride + (size_t)(n0 + n) * 1024 + k0 + k8) = w; }
}
__device__ void phase_wscaled(const Params& p, unsigned char* smem) {
    const int tid = tid_opaque();
    const float* mod = (const float*)(p.ws + WS_MOD);
    float* av = (float*)smem;
#pragma unroll 1
    for (int c = 0; c < 3; ++c) {
        const int N = (c == 1) ? 2048 : 5632;
        const float* avec = c == 0 ? mod + 4 * 1024 : c == 1 ? mod + 61440 + 1 * 1024 : mod + 61440 + 4 * 1024;
        const bf16_t* Bt = c == 0 ? (const bf16_t*)(p.ws + WS_WFFN_IN) : c == 1 ? (const bf16_t*)(p.ws + WS_WCD_IN) : (const bf16_t*)(p.ws + WS_WFFN_IN) + (size_t)5632 * 1024;
        bf16_t* dst = c == 0 ? (bf16_t*)(p.ws + WS_WF0) : c == 1 ? (bf16_t*)((unsigned char*)p.out + DO_WCD) : (bf16_t*)((unsigned char*)p.out + DO_WF1);
        const size_t sstr = (size_t)N * 1024;
        __syncthreads();
        for (int i = tid; i < 10240; i += 512) av[i] = avec[(size_t)(i >> 10) * 6144 + (i & 1023)];
        __syncthreads();
        const int nchunk = N * 128;
        for (int ch = blockIdx.x * 512 + tid; ch < nchunk; ch += gridDim.x * 512) {
            const int k8 = (ch & 127) * 8;
            const u32x4 wv = *(const u32x4*)(Bt + (size_t)ch * 8);
            float f[8];
#pragma unroll
            for (int e = 0; e < 4; ++e) { f[2 * e] = __uint_as_float(wv[e] << 16); f[2 * e + 1] = __uint_as_float(wv[e] & 0xffff0000u); }
#pragma unroll
            for (int sq = 0; sq < 10; ++sq) { const f32x4 a0 = *(const f32x4*)(av + sq * 1024 + k8), a1 = *(const f32x4*)(av + sq * 1024 + k8 + 4);
                u32x4 w; w.x = pk2(f[0] * a0[0], f[1] * a0[1]); w.y = pk2(f[2] * a0[2], f[3] * a0[3]); w.z = pk2(f[4] * a1[0], f[5] * a1[1]); w.w = pk2(f[6] * a1[2], f[7] * a1[3]);
                *(u32x4*)(dst + (size_t)sq * sstr + (size_t)ch * 8) = w; }
        }
    }
    __syncthreads();
}
__device__ void phase_bias(const Params& p, unsigned char* smem) {
    const int tid = tid_opaque(), lane = tid & 63, wave = tid >> 6, nw = gridDim.x * 8;
    float* sh = (float*)smem;
    const float* mod = (const float*)(p.ws + WS_MOD);
    float* biasb = (float*)(p.ws + WS_BIAS);
#pragma unroll 1
    for (int c = 0; c < 3; ++c) {
        const int N = (c == 1) ? 2048 : 5632;
        const float* shp = mod + (size_t)(c == 0 ? 0 : 1) * 61440 + (c == 1 ? 0 : 3) * 1024;
        const bf16_t* Bt = c == 0 ? (const bf16_t*)(p.ws + WS_WFFN_IN) : c == 1 ? (const bf16_t*)(p.ws + WS_WCD_IN) : (const bf16_t*)(p.ws + WS_WFFN_IN) + (size_t)5632 * 1024;
        float* bo = biasb + (c == 0 ? 0 : c == 1 ? 56320 : 56320 + 20480);
        __syncthreads();
        for (int i = tid; i < 10240; i += 512) sh[i] = shp[(size_t)(i >> 10) * 6144 + (i & 1023)];
        __syncthreads();
        for (int n = blockIdx.x * 8 + wave; n < N; n += nw) {
            const u32x4 w0 = *(const u32x4*)(Bt + (size_t)n * 1024 + lane * 16), w1 = *(const u32x4*)(Bt + (size_t)n * 1024 + lane * 16 + 8);
            float wf[16];
#pragma unroll
            for (int e = 0; e < 4; ++e) { wf[2 * e] = __uint_as_float(w0[e] << 16); wf[2 * e + 1] = __uint_as_float(w0[e] & 0xffff0000u); wf[8 + 2 * e] = __uint_as_float(w1[e] << 16); wf[8 + 2 * e + 1] = __uint_as_float(w1[e] & 0xffff0000u); }
            float my = 0.f;
#pragma unroll
            for (int sq = 0; sq < 10; ++sq) { float d = 0.f;
#pragma unroll
                for (int q = 0; q < 4; ++q) { const f32x4 b = *(const f32x4*)(sh + sq * 1024 + lane * 16 + q * 4); d += wf[q * 4] * b[0] + wf[q * 4 + 1] * b[1] + wf[q * 4 + 2] * b[2] + wf[q * 4 + 3] * b[3]; }
                d = wave_sum(d); if (lane == sq) my = d; }
            if (lane < 10) bo[(size_t)lane * N + n] = my;
        }
    }
    __syncthreads();
}

__device__ void phase_conv(const Params& p, unsigned char* smem) {
    const int tid = tid_opaque(), lane = tid & 63, wave = tid >> 6;
    const bf16_t* P0 = (const bf16_t*)(p.ws + WS_P);
    bf16_t* U = (bf16_t*)((unsigned char*)p.out + DO_U);
    bf16_t* gt = (bf16_t*)smem;
    float* zt = (float*)(smem + 94 * 1024);
    const float* wa = p.in[9];
    const float* wb = p.in[10];
    float w[31];
#pragma unroll
    for (int k = 0; k < 31; ++k) w[k] = wb[k * 512 + tid];
    const float bias = p.in[11][tid];
    float lg[8], lb[8];
#pragma unroll
    for (int i = 0; i < 8; ++i) { lg[i] = p.in[12][lane * 8 + i]; lb[i] = p.in[13][lane * 8 + i]; }
    const int ntiles = T_TOK / 64;
#define CONV_STAGE_LOAD(tile_, SG) do { const int t0_ = (tile_) * 64, seq_ = seq_of(t0_); \
        const int s0_ = seq_ < 8 ? seq_ * 8192 : T_P + (seq_ - 8) * 16384, s1_ = s0_ + (seq_ < 8 ? 8192 : 16384); \
        _Pragma("unroll") for (int j = 0; j < 12; ++j) { const int i = tid + 512 * j, r = i >> 6, ch = i & 63, tok = t0_ - 15 + r; \
            SG[j] = (u32x4){0u, 0u, 0u, 0u}; \
            if (i < 94 * 64 && tok >= s0_ && tok < s1_) SG[j] = *(const u32x4*)(P0 + (size_t)tok * 1536 + 1024 + ch * 8); } } while (0)
    u32x4 sg[12];
    if ((int)blockIdx.x < ntiles) CONV_STAGE_LOAD((int)blockIdx.x, sg);
    for (int tile = blockIdx.x; tile < ntiles; tile += gridDim.x) {
        const int t0 = tile * 64, seq = seq_of(t0);
        const int s0 = seq < 8 ? seq * 8192 : T_P + (seq - 8) * 16384, s1 = s0 + (seq < 8 ? 8192 : 16384);
#pragma unroll
        for (int j = 0; j < 12; ++j) { const int i = tid + 512 * j, r = i >> 6, ch = i & 63; if (i < 94 * 64) *(u32x4*)(gt + r * 512 + ch * 8) = sg[j]; }
        __syncthreads();
        if (tile + (int)gridDim.x < ntiles) CONV_STAGE_LOAD(tile + (int)gridDim.x, sg);
#pragma unroll 1
        for (int grp = 0; grp < 4; ++grp) {
            u32x4 yab[2], yx0[2], yxm[2], yxp[2];
#pragma unroll
            for (int j = 0; j < 2; ++j) { const int i = tid + 512 * j, t = grp * 16 + (i >> 6), ch = i & 63, tok = t0 + t, c0 = ch * 8;
                const bf16_t* rp = P0 + (size_t)tok * 1536;
                yab[j] = *(const u32x4*)(rp + c0); yx0[j] = *(const u32x4*)(rp + 512 + c0);
                yxm[j] = (u32x4){0u, 0u, 0u, 0u}; yxp[j] = (u32x4){0u, 0u, 0u, 0u};
                if (tok - 1 >= s0) yxm[j] = *(const u32x4*)(rp - 1536 + 512 + c0);
                if (tok + 1 < s1) yxp[j] = *(const u32x4*)(rp + 1536 + 512 + c0); }
            float g[46];
#pragma unroll
            for (int i = 0; i < 46; ++i) g[i] = bf2f(gt[(grp * 16 + i) * 512 + tid]);
#pragma unroll
            for (int t = 0; t < 16; ++t) { float a = bias;
#pragma unroll
                for (int k = 0; k < 31; ++k) a = fmaf(w[k], g[t + k], a);
                zt[t * 512 + tid] = a; }
            __syncthreads();
#pragma unroll
            for (int tt = 0; tt < 2; ++tt) { const int t = wave * 2 + tt;
                const f32x4 z0 = *(const f32x4*)(zt + t * 512 + lane * 8), z1 = *(const f32x4*)(zt + t * 512 + lane * 8 + 4);
                float s = (z0[0] + z0[1]) + (z0[2] + z0[3]) + (z1[0] + z1[1]) + (z1[2] + z1[3]);
                s = wave_sum(s); const float mu = s * (1.0f / 512.0f);
                const f32x4 d0 = z0 - mu, d1 = z1 - mu;
                float q = d0[0] * d0[0] + d0[1] * d0[1] + d0[2] * d0[2] + d0[3] * d0[3] + d1[0] * d1[0] + d1[1] * d1[1] + d1[2] * d1[2] + d1[3] * d1[3];
                q = wave_sum(q); const float rstd = __builtin_amdgcn_rsqf(q * (1.0f / 512.0f) + EPSV);
                float r[8];
#pragma unroll
                for (int e = 0; e < 8; ++e) { const float d = e < 4 ? d0[e & 3] : d1[e & 3]; const float y = d * rstd * lg[e] + lb[e]; r[e] = y * sigm(y); }
                u32x4 o; o.x = pk2(r[0], r[1]); o.y = pk2(r[2], r[3]); o.z = pk2(r[4], r[5]); o.w = pk2(r[6], r[7]);
                *(u32x4*)(U + (size_t)(t0 + grp * 16 + t) * 1024 + 512 + lane * 8) = o; }
#pragma unroll
            for (int j = 0; j < 2; ++j) { const int i = tid + 512 * j, t = grp * 16 + (i >> 6), ch = i & 63, tok = t0 + t, c0 = ch * 8;
                const u32x4 ab = yab[j], x0 = yx0[j], xm = yxm[j], xp = yxp[j];
                const f32x4 w0a = *(const f32x4*)(wa + c0), w0b = *(const f32x4*)(wa + c0 + 4), w1a = *(const f32x4*)(wa + 512 + c0), w1b = *(const f32x4*)(wa + 512 + c0 + 4),
                            w2a = *(const f32x4*)(wa + 1024 + c0), w2b = *(const f32x4*)(wa + 1024 + c0 + 4);
                float r[8];
#pragma unroll
                for (int e = 0; e < 8; ++e) { const unsigned sh = (e & 1) * 16; const int q = e >> 1;
                    const float fab = __uint_as_float((ab[q] >> sh) << 16), f0 = __uint_as_float((x0[q] >> sh) << 16), fm = __uint_as_float((xm[q] >> sh) << 16), fp = __uint_as_float((xp[q] >> sh) << 16);
                    const float k0 = e < 4 ? w0a[e & 3] : w0b[e & 3], k1 = e < 4 ? w1a[e & 3] : w1b[e & 3], k2 = e < 4 ? w2a[e & 3] : w2b[e & 3];
                    r[e] = fab * (k0 * fm + k1 * f0 + k2 * fp); }
                u32x4 o; o.x = pk2(r[0], r[1]); o.y = pk2(r[2], r[3]); o.z = pk2(r[4], r[5]); o.w = pk2(r[6], r[7]);
                *(u32x4*)(U + (size_t)tok * 1024 + c0) = o; }
            __syncthreads();
        }
    }
#undef CONV_STAGE_LOAD
}

__device__ void phase_sg(const Params& p, unsigned char* smem) {
    const int tid = tid_opaque(), lane = tid & 63, wave = tid >> 6, fr = lane & 15, fq = lane >> 4;
    const bf16_t* P1 = (const bf16_t*)(p.ws + WS_P);
    bf16_t* U = (bf16_t*)((unsigned char*)p.out + DO_U);
    const bf16_t* Wsb = (const bf16_t*)(p.ws + WS_WS);
    float* st = (float*)smem;
    bf16_t* vnT = (bf16_t*)(smem + 1024);
    constexpr int PITCH = 136;
    const int pp = wave * 16 + fr;
#define SG_LOAD(h_, WF, UU, BS, VA) do { \
        _Pragma("unroll") for (int kk = 0; kk < 4; ++kk) WF[kk] = *(const bf16x8*)(Wsb + (size_t)((h_) * 128 + pp) * 128 + kk * 32 + fq * 8); \
        _Pragma("unroll") for (int mt = 0; mt < 8; ++mt) UU[mt] = *(const u32x2*)(P1 + (size_t)(t0 + pp) * 2048 + (h_) * 128 + mt * 16 + 4 * fq); \
        BS = p.in[19][(h_) * 128 + pp]; \
        _Pragma("unroll") for (int j = 0; j < 4; ++j) { const int item = tid + 512 * j, q = item & 127, dc = item >> 7; VA[j] = *(const u32x4*)(P1 + (size_t)(t0 + q) * 2048 + 768 + (h_) * 128 + dc * 8); } \
    } while (0)
    for (int chunk = blockIdx.x; chunk < T_TOK / 128; chunk += gridDim.x) {
        const int t0 = chunk * 128;
        bf16x8 wfN[4]; u32x2 uuN[8]; float bsN; u32x4 vaN[4];
        SG_LOAD(0, wfN, uuN, bsN, vaN);
#pragma unroll 1
        for (int half = 0; half < 2; ++half) {
            u32x4 av[8], bv[8];
#pragma unroll
            for (int tt = 0; tt < 8; ++tt) { const int q = wave * 16 + half * 8 + tt; const bf16_t* vp = P1 + (size_t)(t0 + q) * 2048 + 768;
                av[tt] = *(const u32x4*)(vp + lane * 8); bv[tt] = (u32x4){0u, 0u, 0u, 0u}; if (lane < 32) bv[tt] = *(const u32x4*)(vp + 512 + lane * 8); }
#pragma unroll
            for (int tt = 0; tt < 8; ++tt) { const int q = wave * 16 + half * 8 + tt; const u32x4 a = av[tt], b = bv[tt];
                float s = 0.f, ss = 0.f;
#pragma unroll
                for (int e = 0; e < 4; ++e) { const float x0 = __uint_as_float(a[e] << 16), x1 = __uint_as_float(a[e] & 0xffff0000u), y0 = __uint_as_float(b[e] << 16), y1 = __uint_as_float(b[e] & 0xffff0000u);
                    s += (x0 + x1) + (y0 + y1); ss += (x0 * x0 + x1 * x1) + (y0 * y0 + y1 * y1); }
                s = wave_sum(s); ss = wave_sum(ss);
                const float mu = s * (1.0f / 768.0f); const float var = ss * (1.0f / 768.0f) - mu * mu;
                if (lane == 0) { st[q * 2] = mu; st[q * 2 + 1] = __builtin_amdgcn_rsqf(fmaxf(var, 0.f) + EPSV); } }
        }
        __syncthreads();
#pragma unroll
        for (int h = 0; h < 6; ++h) {
            bf16x8 wf[4]; u32x2 uu[8]; u32x4 va[4]; const float bsv = bsN;
#pragma unroll
            for (int i = 0; i < 4; ++i) { wf[i] = wfN[i]; va[i] = vaN[i]; }
#pragma unroll
            for (int i = 0; i < 8; ++i) uu[i] = uuN[i];
#pragma unroll
            for (int j = 0; j < 4; ++j) { const int item = tid + 512 * j, q = item & 127, dc = item >> 7;
                const u32x4 a = va[j];
                const float mu = st[q * 2], rs = st[q * 2 + 1];
                const float* lg = p.in[16] + h * 128 + dc * 8; const float* lb = p.in[17] + h * 128 + dc * 8;
#pragma unroll
                for (int e = 0; e < 8; ++e) { const float x = (e & 1) ? __uint_as_float(a[e >> 1] & 0xffff0000u) : __uint_as_float(a[e >> 1] << 16);
                    const float y = (x - mu) * rs * lg[e] + lb[e];
                    vnT[(dc * 8 + e) * PITCH + q] = (bf16_t)(pk2(y, 0.f) & 0xffffu); } }
            __syncthreads();
            if (h < 5) SG_LOAD(h + 1, wfN, uuN, bsN, vaN);
            const size_t tokoff = (size_t)(t0 + pp);
#pragma unroll
            for (int mt = 0; mt < 8; ++mt) { f32x4 acc = (f32x4){0.f, 0.f, 0.f, 0.f};
#pragma unroll
                for (int kk = 0; kk < 4; ++kk) { const bf16x8 af = *(const bf16x8*)(vnT + (mt * 16 + fr) * PITCH + kk * 32 + fq * 8);
                    acc = __builtin_amdgcn_mfma_f32_16x16x32_bf16(af, wf[kk], acc, 0, 0, 0); }
                const int col = h * 128 + mt * 16 + 4 * fq;
                const u32x2 u2 = uu[mt];
                const float u0 = __uint_as_float(u2.x << 16), u1 = __uint_as_float(u2.x & 0xffff0000u), u2f = __uint_as_float(u2.y << 16), u3 = __uint_as_float(u2.y & 0xffff0000u);
                u32x2 o; o.x = pk2(u0 * (acc[0] + bsv), u1 * (acc[1] + bsv)); o.y = pk2(u2f * (acc[2] + bsv), u3 * (acc[3] + bsv));
                *(u32x2*)(U + tokoff * 1024 + col) = o; }
            __syncthreads();
        }
    }
#undef SG_LOAD
}

__device__ void phase_fft1(const Params& p, unsigned char* smem) {
    const int tid = tid_opaque(), lane = tid & 63, wave = tid >> 6, fr = lane & 15, fq = lane >> 4;
    const bf16_t* P1 = (const bf16_t*)(p.ws + WS_P);
    bf16_t* Y1 = (bf16_t*)(p.ws + WS_Y1);
    const bf16_t* D1 = (const bf16_t*)(p.ws + WS_DFT1);
    bf16_t* BT = (bf16_t*)smem;
    constexpr int PITCH = 264;
    bf16x8 af[2][8];
#pragma unroll
    for (int i = 0; i < 2; ++i)
#pragma unroll
        for (int kk = 0; kk < 8; ++kk) af[i][kk] = *(const bf16x8*)(D1 + (size_t)(i * 128 + wave * 16 + fr) * 256 + kk * 32 + fq * 8);
#define F1_DECODE(u_, seq_, b_, cblk_, N2_, tokbase_) do { int rem_; \
        if ((u_) < 2048) { seq_ = (u_) >> 8; rem_ = (u_) & 255; N2_ = 64; tokbase_ = seq_ * 8192; } else { const int u2_ = (u_) - 2048; seq_ = 8 + (u2_ >> 9); rem_ = u2_ & 511; N2_ = 128; tokbase_ = T_P + (seq_ - 8) * 16384; } \
        b_ = rem_ >> 2; cblk_ = rem_ & 3; } while (0)
#define F1_LOAD(u_, V) do { int seq_, b_, cblk_, N2_, tb_; F1_DECODE(u_, seq_, b_, cblk_, N2_, tb_); \
        _Pragma("unroll") for (int j = 0; j < 4; ++j) { const int item = tid + 512 * j, a = item & 127, rest = item >> 7, part = rest >> 3, ch8 = rest & 7; \
            V[j] = *(const u32x4*)(P1 + (size_t)(tb_ + a * N2_ + b_) * 2048 + 1536 + part * 256 + cblk_ * 64 + ch8 * 8); } } while (0)
    u32x4 nx[4];
    if ((int)blockIdx.x < 3072) F1_LOAD((int)blockIdx.x, nx);
    for (int u = blockIdx.x; u < 3072; u += gridDim.x) {
        int seq, b, cblk, N2, tokbase; F1_DECODE(u, seq, b, cblk, N2, tokbase);
#pragma unroll
        for (int j = 0; j < 4; ++j) { const int item = tid + 512 * j, a = item & 127, rest = item >> 7, part = rest >> 3, ch8 = rest & 7;
            const u32x4 v = nx[j];
#pragma unroll
            for (int e = 0; e < 8; ++e) BT[(ch8 * 8 + e) * PITCH + part * 128 + a] = (bf16_t)((e & 1) ? (v[e >> 1] >> 16) : (v[e >> 1] & 0xffffu)); }
        __syncthreads();
        if (u + (int)gridDim.x < 3072) F1_LOAD(u + (int)gridDim.x, nx);
        f32x4 acc[2][4];
#pragma unroll
        for (int i = 0; i < 2; ++i)
#pragma unroll
            for (int nt = 0; nt < 4; ++nt) acc[i][nt] = (f32x4){0.f, 0.f, 0.f, 0.f};
#pragma unroll
        for (int kk = 0; kk < 8; ++kk)
#pragma unroll
            for (int nt = 0; nt < 4; ++nt) { const bf16x8 bfr = *(const bf16x8*)(BT + (nt * 16 + fr) * PITCH + kk * 32 + fq * 8);
                acc[0][nt] = __builtin_amdgcn_mfma_f32_16x16x32_bf16(bfr, af[0][kk], acc[0][nt], 0, 0, 0);
                acc[1][nt] = __builtin_amdgcn_mfma_f32_16x16x32_bf16(bfr, af[1][kk], acc[1][nt], 0, 0, 0); }
        const int ka = wave * 16 + fr, S = N2 * 128;
        const float rev = (float)((ka * b) & (S - 1)) / (float)S; const float cw = __builtin_amdgcn_cosf(rev), sw = __builtin_amdgcn_sinf(rev);
        bf16_t* yp = Y1 + (size_t)(tokbase + ka * N2 + b) * 512 + cblk * 64 + 4 * fq;
#pragma unroll
        for (int nt = 0; nt < 4; ++nt) { const f32x4 yr = acc[0][nt], yi = acc[1][nt];
            const f32x4 zr = yr * cw + yi * sw, zi = yi * cw - yr * sw;
            u32x2 o; o.x = pk2(zr[0], zr[1]); o.y = pk2(zr[2], zr[3]); *(u32x2*)(yp + nt * 16) = o;
            o.x = pk2(zi[0], zi[1]); o.y = pk2(zi[2], zi[3]); *(u32x2*)(yp + 256 + nt * 16) = o; }
        __syncthreads();
    }
#undef F1_LOAD
#undef F1_DECODE
}
__device__ void phase_fft2(const Params& p, unsigned char* smem) {
    const int tid = tid_opaque(), lane = tid & 63, wave = tid >> 6, fr = lane & 15, fq = lane >> 4;
    const bf16_t* Y1 = (const bf16_t*)(p.ws + WS_Y1);
    bf16_t* U = (bf16_t*)((unsigned char*)p.out + DO_U);
    bf16_t* BT = (bf16_t*)smem;
    constexpr int PITCH = 264;
#define F2_DECODE(u_, N2_, lg2_, tokbase_, ka_, cblk_) do { \
        if ((u_) < 4096) { N2_ = 64; lg2_ = 6; tokbase_ = ((u_) >> 9) * 8192; } else { N2_ = 128; lg2_ = 7; tokbase_ = T_P + (((u_) - 4096) >> 9) * 16384; } \
        const int rem_ = (u_) & 511; ka_ = rem_ >> 2; cblk_ = rem_ & 3; } while (0)
#define F2_LOAD(u_, V) do { int N2_, lg2_, tb_, ka_, cblk_; F2_DECODE(u_, N2_, lg2_, tb_, ka_, cblk_); \
        _Pragma("unroll") for (int j = 0; j < 4; ++j) { const int item = tid + 512 * j; if (item < N2_ * 16) { const int b = item & (N2_ - 1), rest = item >> lg2_, part = rest >> 3, ch8 = rest & 7; \
            V[j] = *(const u32x4*)(Y1 + (size_t)(tb_ + ka_ * N2_ + b) * 512 + part * 256 + cblk_ * 64 + ch8 * 8); } } } while (0)
    u32x4 nx[4];
#pragma unroll
    for (int j = 0; j < 4; ++j) nx[j] = (u32x4){0u, 0u, 0u, 0u};
    if ((int)blockIdx.x < 5120) F2_LOAD((int)blockIdx.x, nx);
    for (int u = blockIdx.x; u < 5120; u += gridDim.x) {
        int N2, lg2, tokbase, ka, cblk; F2_DECODE(u, N2, lg2, tokbase, ka, cblk);
        const bf16_t* D2 = (N2 == 128) ? (const bf16_t*)(p.ws + WS_DFT2B) : (const bf16_t*)(p.ws + WS_DFT2A);
#pragma unroll
        for (int j = 0; j < 4; ++j) { const int item = tid + 512 * j; if (item < N2 * 16) { const int b = item & (N2 - 1), rest = item >> lg2, part = rest >> 3, ch8 = rest & 7;
            const u32x4 v = nx[j];
#pragma unroll
            for (int e = 0; e < 8; ++e) BT[(ch8 * 8 + e) * PITCH + part * N2 + b] = (bf16_t)((e & 1) ? (v[e >> 1] >> 16) : (v[e >> 1] & 0xffffu)); } }
        __syncthreads();
        if (u + (int)gridDim.x < 5120) F2_LOAD(u + (int)gridDim.x, nx);
        const int nb = (N2 == 128) ? wave : (wave & 3), mt0 = (N2 == 128) ? 0 : 2 * (wave >> 2), nmt = (N2 == 128) ? 4 : 2, ksteps = N2 >> 4, K2 = 2 * N2;
        f32x4 acc[4];
#pragma unroll
        for (int i = 0; i < 4; ++i) acc[i] = (f32x4){0.f, 0.f, 0.f, 0.f};
        for (int kk = 0; kk < ksteps; ++kk) { const bf16x8 df = *(const bf16x8*)(D2 + (size_t)(nb * 16 + fr) * K2 + kk * 32 + fq * 8);
#pragma unroll
            for (int i = 0; i < 4; ++i) if (i < nmt) { const bf16x8 bfr = *(const bf16x8*)(BT + ((mt0 + i) * 16 + fr) * PITCH + kk * 32 + fq * 8);
                acc[i] = __builtin_amdgcn_mfma_f32_16x16x32_bf16(bfr, df, acc[i], 0, 0, 0); } }
        const float scale = (N2 == 128) ? 9.765625e-4f : 1.3810679e-3f;
        const int kb = nb * 16 + fr;
        bf16_t* up = U + (size_t)(tokbase + ka + 128 * kb) * 1024 + 768 + cblk * 64 + 4 * fq;
#pragma unroll
        for (int i = 0; i < 4; ++i) if (i < nmt) { const f32x4 y = acc[i] * scale; u32x2 o; o.x = pk2(y[0], y[1]); o.y = pk2(y[2], y[3]); *(u32x2*)(up + (mt0 + i) * 16) = o; }
        __syncthreads();
    }
#undef F2_LOAD
#undef F2_DECODE
}

#define XB_TMO      128
#define XB_XCNT(j)  (256  + 64 * (j))
#define XB_XSUB(j)  (1280 + 64 * (j))
#define XB_XGEN(j)  (2304 + 64 * (j))
#define XB_TOP      3328
#define XB_TOPGEN   3392
#define XCD_BAR_WORDS 3456
#define XB_SPIN_CAP (1u << 22)
__device__ __forceinline__ unsigned xb_ld(unsigned* p)              { return __hip_atomic_load(p, __ATOMIC_RELAXED, __HIP_MEMORY_SCOPE_AGENT); }
__device__ __forceinline__ unsigned xb_add(unsigned* p, unsigned v) { return __hip_atomic_fetch_add(p, v, __ATOMIC_RELAXED, __HIP_MEMORY_SCOPE_AGENT); }
__device__ __forceinline__ unsigned xb_xcc_id() { return (unsigned)__builtin_amdgcn_s_getreg((3 << 11) | 20) & 0xFu; }
#define XB_SPIN(cond, bar) do { unsigned _sp = 0; while (cond) { __builtin_amdgcn_s_sleep(1); \
    if ((++_sp & 255u) == 0u) { if (xb_ld(&(bar)[XB_TMO])) break; if (_sp > XB_SPIN_CAP) { atomicAdd(&(bar)[XB_TMO], 1u); break; } } } } while (0)
struct XcdBarrier { unsigned* bar; unsigned x; volatile LAS unsigned* st; };
__device__ __forceinline__ XcdBarrier xcd_barrier_post(unsigned* bar, volatile LAS unsigned* st) {
    XcdBarrier b; b.bar = bar; b.x = xb_xcc_id(); b.st = st;
    if (threadIdx.x == 0) (void)xb_add(&bar[XB_XCNT(b.x)], 1u);
    return b;
}
__device__ __forceinline__ void xcd_barrier_complete(unsigned* bar, unsigned x, unsigned& nloc, unsigned& nx) {
    const unsigned G = gridDim.x * gridDim.y * gridDim.z;
    unsigned sum, cnt, mine, sp = 0u;
    for (;;) {
        sum = 0u; cnt = 0u; mine = 0u;
#pragma unroll
        for (unsigned j = 0; j < 16; ++j) { const unsigned c = xb_ld(&bar[XB_XCNT(j)]); sum += c; cnt += (c > 0u) ? 1u : 0u; mine = (j == x) ? c : mine; }
        if (sum == G) break;
        __builtin_amdgcn_s_sleep(1);
        if ((++sp & 255u) == 0u) { if (xb_ld(&bar[XB_TMO])) break; if (sp > XB_SPIN_CAP) { atomicAdd(&bar[XB_TMO], 1u); break; } }
    }
    nloc = mine > 0u ? mine : 1u; nx = cnt > 0u ? cnt : 1u;
}
__device__ __forceinline__ void xcd_barrier(const XcdBarrier& b) {
    asm volatile("s_waitcnt vmcnt(0)" ::: "memory");
    __syncthreads();
    if (threadIdx.x == 0) {
        unsigned* bar = b.bar;
        __builtin_amdgcn_s_waitcnt(0);
        unsigned nloc = b.st[0], nx = b.st[1];
        if (nloc == 0u) { xcd_barrier_complete(bar, b.x, nloc, nx); b.st[0] = nloc; b.st[1] = nx; }
        const unsigned old = xb_add(&bar[XB_XSUB(b.x)], 1u);
        const unsigned gen = old / nloc;
        if (old + 1u == (gen + 1u) * nloc) {
            __builtin_amdgcn_fence(__ATOMIC_RELEASE, "agent");
            asm volatile("s_waitcnt vmcnt(0)" ::: "memory");
            const unsigned og = xb_add(&bar[XB_TOP], 1u);
            const unsigned tg = og / nx;
            if (og + 1u == (tg + 1u) * nx) xb_add(&bar[XB_TOPGEN], 1u);
            else XB_SPIN(xb_ld(&bar[XB_TOPGEN]) == tg, bar);
            __builtin_amdgcn_fence(__ATOMIC_ACQUIRE, "agent");
            xb_add(&bar[XB_XGEN(b.x)], 1u);
            asm volatile("s_waitcnt vmcnt(0)" ::: "memory");
        } else {
            XB_SPIN(xb_ld(&bar[XB_XGEN(b.x)]) == gen, bar);
            __builtin_amdgcn_fence(__ATOMIC_ACQUIRE, "agent");
            asm volatile("s_waitcnt vmcnt(0)" ::: "memory");
        }
    }
    __syncthreads();
}

__device__ __forceinline__ int opaque(int v) { int r; asm volatile("s_mov_b32 %0, %1" : "=s"(r) : "s"(v)); return r; }
#define XB_EXIT 3456
__device__ unsigned g_xbar[XB_EXIT + 64];
__global__ void __launch_bounds__(512, 2) fwd_mega(Params p) {
    extern __shared__ __attribute__((aligned(16))) unsigned char smem[];
    cg::grid_group grid = cg::this_grid();
    LAS unsigned char* lds = (LAS unsigned char*)smem;
    unsigned char* ws = p.ws;
    const int lo = p.ph_lo, hi = p.ph_hi, G = gridDim.x, bid = blockIdx.x;
    const float* mod = (const float*)(ws + WS_MOD);
    bf16_t* H = (bf16_t*)(ws + WS_H);
    bf16_t* P = (bf16_t*)(ws + WS_P);
    float* out = p.out;
    bf16_t* U = (bf16_t*)((unsigned char*)p.out + DO_U);
    bf16_t* X = H;
    float* rowpart = (float*)(ws + WS_RP);
    const float* biasb = (const float*)(ws + WS_BIAS);
    bool first = true;
    volatile LAS unsigned* xst = (volatile LAS unsigned*)(lds + 131072);
    if (threadIdx.x == 0) { xst[0] = 0u; xst[1] = 0u; }
    __syncthreads();
    XcdBarrier xbar = xcd_barrier_post(g_xbar, xst);
    int nseam = 0;
#if PROBE_SYNCS
    for (int i = 0; i < PROBE_SYNCS; ++i) grid.sync();
#endif
#pragma unroll 1
    for (int ph = lo; ph < hi; ++ph) {
        if (ph == 5 || ph == 8 || ph == 13) continue;
#if PROBE_MASK
        for (int rep = 0; rep < (((PROBE_MASK >> ph) & 1) ? 2 : 1); ++rep) {
#endif
        if (!first) { if (hi > 1000) grid.sync(); else xcd_barrier(xbar); ++nseam; }
        first = false;
        const int l = ph >= 8 ? 1 : 0;
        const float* modl = mod + (size_t)l * 61440;
        if (ph == 0) phase_prep(p, smem);
        else if (ph == 1) { phase_wscaled(p, smem); phase_bias(p, smem); phase_norm(p.in[0], p.in[1], mod, 1, 0, H); }
        else if (ph == 2) { pg8::Gemm g{H, (const bf16_t*)(ws + WS_WAB_IN), T_TOK, opaque(2560), opaque(1024), 0}; pg8::StaticOrder S; S.init(T_TOK, g.N, G, bid);
            EpiAct<0> E{P, 1536, nullptr, nullptr, 0}; pg8::gemm_phase<EpiAct<0>, pg8::StaticOrder>(lds, g, S, E); }
#if PROBE_HOT
        else if (ph == 3) { { struct HotOrder : pg8::StaticOrder { __device__ bool next(int i, Unit& u) const { if (!pg8::StaticOrder::next(i, u)) return false; u.pm = 0; u.pn = u.pn % PROBE_HOT; return true; } };
            pg8::Gemm g{H, (const bf16_t*)(ws + WS_WAB_IN), T_TOK, opaque(2560), opaque(1024), 0}; HotOrder S; S.init(T_TOK, g.N, G, bid);
            EpiAct<2> E{(bf16_t*)(ws + WS_END), 2560, nullptr, nullptr, 0}; pg8::gemm_phase<EpiAct<2>, HotOrder>(lds, g, S, E); }
            grid.sync(); phase_conv(p, smem); }
#else
        else if (ph == 3) phase_conv(p, smem);
#endif
        else if (ph == 4) { pg8::Gemm g{U, (const bf16_t*)(ws + WS_WAB_OUT), T_TOK, opaque(1024), opaque(1024), 0}; pg8::StaticOrder S; S.init(T_TOK, g.N, G, bid);
            EpiRes<true> E{p.in[0], p.in[1], X, mod + 2 * 1024, rowpart}; pg8::gemm_phase<EpiRes<true>, pg8::StaticOrder>(lds, g, S, E); }
        else if (ph == 7 || ph == 12 || ph == 15) {
            const bool ffn = (ph != 12);
            const bf16_t* A = ffn ? P : U;
            const bf16_t* Bt = ph == 12 ? (const bf16_t*)(ws + WS_WCD_OUT) : (const bf16_t*)(ws + WS_WFFN_OUT) + (size_t)l * 1024 * 2816;
            pg8::Gemm g{A, Bt, T_TOK, opaque(1024), opaque(ffn ? DFF : 1024), 0}; pg8::StaticOrder S; S.init(T_TOK, g.N, G, bid);
            const int ri = ph == 7 ? 1 : ph == 12 ? 2 : 3;
            EpiRes<false> E{nullptr, nullptr, X, modl + (ffn ? 5 : 2) * 1024, rowpart + (size_t)ri * T_TOK * 16};
            pg8::gemm_phase<EpiRes<false>, pg8::StaticOrder>(lds, g, S, E);
        }
        else if (ph == 6 || ph == 14) { const bf16_t* Bt = l == 0 ? (const bf16_t*)(ws + WS_WF0) : (const bf16_t*)((unsigned char*)p.out + DO_WF1);
            pg8::Gemm g{X, Bt, T_TOK, opaque(5632), opaque(1024), (size_t)5632 * 1024 * 2}; pg8::StaticOrder S; S.init(T_TOK, g.N, G, bid);
            EpiAct<1> E{P, DFF, rowpart + (size_t)(l == 0 ? 0 : 2) * T_TOK * 16, biasb + (l == 0 ? 0 : 56320 + 20480), 5632}; pg8::gemm_phase<EpiAct<1>, pg8::StaticOrder>(lds, g, S, E); }
        else if (ph == 9) { pg8::Gemm g{X, (const bf16_t*)((unsigned char*)p.out + DO_WCD), T_TOK, opaque(2048), opaque(1024), (size_t)2048 * 1024 * 2}; pg8::StaticOrder S; S.init(T_TOK, g.N, G, bid);
            EpiAct<2> E{P, 2048, rowpart + (size_t)1 * T_TOK * 16, biasb + 56320, 2048}; pg8::gemm_phase<EpiAct<2>, pg8::StaticOrder>(lds, g, S, E); }
#if PROBE_SG
        else if (ph == 10) { phase_sg(p, smem); __syncthreads(); phase_sg(p, smem); __syncthreads(); phase_fft1(p, smem); }
#else
        else if (ph == 10) { phase_sg(p, smem); __syncthreads(); phase_fft1(p, smem); }
#endif
        else if (ph == 11) phase_fft2(p, smem);
        else if (ph == 16) phase_final(out, X, rowpart + (size_t)3 * T_TOK * 16, p.in[23]);
#if PROBE_MASK
        }
#endif
    }
    __syncthreads();
    if (threadIdx.x == 0) {
        const unsigned old = xb_add(&g_xbar[XB_EXIT], 1u);
        if (old + 1u == (unsigned)gridDim.x) {
            for (unsigned j = 0; j < 16; ++j) { __hip_atomic_store(&g_xbar[XB_XCNT(j)], 0u, __ATOMIC_RELAXED, __HIP_MEMORY_SCOPE_AGENT); __hip_atomic_store(&g_xbar[XB_XSUB(j)], 0u, __ATOMIC_RELAXED, __HIP_MEMORY_SCOPE_AGENT);
                __hip_atomic_store(&g_xbar[XB_XGEN(j)], 0u, __ATOMIC_RELAXED, __HIP_MEMORY_SCOPE_AGENT); }
            __hip_atomic_store(&g_xbar[XB_TOP], 0u, __ATOMIC_RELAXED, __HIP_MEMORY_SCOPE_AGENT); __hip_atomic_store(&g_xbar[XB_TOPGEN], 0u, __ATOMIC_RELAXED, __HIP_MEMORY_SCOPE_AGENT);
            __hip_atomic_store(&g_xbar[XB_TMO], 0u, __ATOMIC_RELAXED, __HIP_MEMORY_SCOPE_AGENT); __hip_atomic_store(&g_xbar[XB_EXIT], 0u, __ATOMIC_RELAXED, __HIP_MEMORY_SCOPE_AGENT);
        }
    }
}

#ifndef N_LAUNCH_SPLIT
#define N_LAUNCH_SPLIT 0
#endif
extern "C" void kernel_launch(void* const* d_in, const int* in_sizes, int n_in, void* d_out, int out_size, void* d_ws, size_t ws_size, hipStream_t stream) {
    static int grid = 0;
    if (grid == 0) {
        if (n_in != 24 || ws_size < WS_END) { fprintf(stderr, "kernel_launch: unexpected n_in %d or ws_size %zu (need %zu)\n", n_in, ws_size, (size_t)WS_END); grid = -1; return; }
        int dev = 0, cus = 0, per_cu = 0;
        hipGetDevice(&dev);
        hipDeviceGetAttribute(&cus, hipDeviceAttributeMultiprocessorCount, dev);
        if (hipFuncSetAttribute((const void*)fwd_mega, hipFuncAttributeMaxDynamicSharedMemorySize, LDS_BYTES) != hipSuccess) { fprintf(stderr, "kernel_launch: hipFuncSetAttribute failed\n"); grid = -1; return; }
        if (hipOccupancyMaxActiveBlocksPerMultiprocessor(&per_cu, (const void*)fwd_mega, 512, LDS_BYTES) != hipSuccess || per_cu < 1) { fprintf(stderr, "kernel_launch: occupancy query says %d\n", per_cu); per_cu = 1; }
        (void)hipGetLastError();
        grid = cus;
        if (grid > 256) grid = 256;
    }
    if (grid < 0) return;
    Params p{};
    for (int i = 0; i < 24; ++i) p.in[i] = (const float*)d_in[i];
    p.out = (float*)d_out; p.ws = (unsigned char*)d_ws;
#if N_LAUNCH_SPLIT
    for (int ph = 0; ph < 17; ++ph) { p.ph_lo = ph; p.ph_hi = ph + 1; void* args[] = {&p};
        hipError_t e = hipLaunchCooperativeKernel((const void*)fwd_mega, dim3(grid), dim3(512), args, LDS_BYTES, stream);
        if (e != hipSuccess) { fprintf(stderr, "cooperative launch failed: %s (grid %d)\n", hipGetErrorString(e), grid); break; } }
#else
    p.ph_lo = 0; p.ph_hi = 17; void* args[] = {&p};
    hipError_t e = hipLaunchCooperativeKernel((const void*)fwd_mega, dim3(grid), dim3(512), args, LDS_BYTES, stream);
    if (e != hipSuccess) fprintf(stderr, "cooperative launch failed: %s (grid %d)\n", hipGetErrorString(e), grid);
#endif
}
```

```cpp
#include <hip/hip_runtime.h>
#include <hip/hip_cooperative_groups.h>
#include <cstdio>
namespace cg = cooperative_groups;

namespace pg8 {
#define PG8_LAS __attribute__((address_space(3)))
typedef unsigned short bf16_t;
typedef short bf16x8 __attribute__((ext_vector_type(8)));
typedef float f32x4 __attribute__((ext_vector_type(4)));
typedef unsigned u32x4 __attribute__((ext_vector_type(4)));
constexpr int BM = 256, BK = 64, HALF = 128, HTB = HALF * BK * 2  , STAGE_BYTES = 8 * HTB, NXCD = 8, WGM = 8;

__host__ __device__ __forceinline__ int lds_byte(int r, int c) { const int st = (r >> 4) * 2 + (c >> 5), rr = r & 15, cc = c & 31, ob = rr * 64 + cc * 2; return st * 1024 + (ob ^ (((ob >> 9) & 1) << 5)); }
__host__ __device__ __forceinline__ void stage_rc(int b, int& R, int& C) { const int st = b / 1024, sb = b % 1024, swz = sb ^ (((sb >> 9) & 1) << 5); R = (st >> 1) * 16 + swz / 64; C = (st & 1) * 32 + (swz % 64) / 2; }
__host__ __device__ __forceinline__ int perm32(int rho) { const int n = rho >> 4, i = rho & 15; return 8 * (i >> 2) + 4 * n + (i & 3); }

struct Unit { int pm, pn; };
struct Gemm { const bf16_t* A; const bf16_t* Bt; int M, N, K; size_t bseq; };
__device__ __forceinline__ int seq_of_pm(int pm) { return pm < 256 ? (pm >> 5) : 8 + ((pm - 256) >> 6); }

struct StaticOrder {
    int nM, nN, nwg, G, c;
    __host__ __device__ void init(int M, int N, int G_, int c_) { nM = M / BM; nN = N / BM; nwg = nM * nN; G = G_; c = c_; }
    __host__ __device__ bool next(int i, Unit& u) const {
        const long L = (long)i * G + c; if (L >= nwg) return false;
        int wgid = (int)L; { const int q = nwg / NXCD, r = nwg % NXCD, xcd = wgid % NXCD, off = wgid / NXCD; wgid = (xcd < r ? xcd * (q + 1) : r * (q + 1) + (xcd - r) * q) + off; }
        const int nig = WGM * nN, gid = wgid / nig, fm = gid * WGM, gsz = (nM - fm) < WGM ? (nM - fm) : WGM;
        u.pm = fm + ((wgid % nig) % gsz); u.pn = (wgid % nig) / gsz; return true;
    }
    __device__ __forceinline__ void a_ready(const Unit&) const {}
    __device__ __forceinline__ void done(const Unit&) const {}
};
__device__ __forceinline__ unsigned cvt_pk_bf16(float lo, float hi) { unsigned r; asm volatile("v_cvt_pk_bf16_f32 %0, %1, %2" : "=v"(r) : "v"(lo), "v"(hi)); return r; }
template <class Epi, class Sched>
__device__ __forceinline__ void gemm_phase(PG8_LAS unsigned char* lds, const Gemm g, const Sched& S, const Epi& E) {
    int tid = threadIdx.x; asm volatile("" : "+v"(tid)); const int wid = __builtin_amdgcn_readfirstlane(tid >> 6), lane = tid & 63, wr = wid >> 2, wc = wid & 3, fr = lane & 15, fq = lane >> 4;
    const int K = g.K, nt = K / BK;
    unsigned voffA[2], voffB[2];
#pragma unroll
    for (int i = 0; i < 2; ++i) { int R, C; stage_rc(tid * 16 + i * 8192, R, C); const int Rb = Epi::PERM ? ((R & ~31) + perm32(R & 31)) : R;
        voffA[i] = (unsigned)(R * K + C) * 2u; voffB[i] = (unsigned)(Rb * K + C) * 2u; }
    const size_t kstep = (size_t)(BK * 2);
    const size_t hstep = (size_t)HALF * K * 2;
    const size_t tstep = 2 * hstep;
    const unsigned ldsw = (unsigned)wid * 1024u;
    const int aoff = lds_byte(wr * 64 + fr, fq * 8), boff = lds_byte(wc * 32 + fr, fq * 8);
#define PG8_SA(b, h) (((b) * 2 + (h)) * HTB)
#define PG8_SB(b, h) ((4 + (b) * 2 + (h)) * HTB)
#define PG8_STAGE(bufoff, gbase, voff, AUX) do { _Pragma("unroll") for (int _i = 0; _i < 2; ++_i) \
        __builtin_amdgcn_global_load_lds((const unsigned*)((const char*)(gbase) + (voff)[_i]), (PG8_LAS unsigned*)(lds + (bufoff) + ldsw + _i * 8192), 16, 0, AUX); } while (0)
#define PG8_LDA(dst, b, h) do { _Pragma("unroll") for (int m = 0; m < 4; ++m) _Pragma("unroll") for (int k = 0; k < 2; ++k) dst[m][k] = *(const PG8_LAS bf16x8*)(lds + PG8_SA(b, h) + aoff + m * 2048 + k * 1024); } while (0)
#define PG8_LDB(dst, b, h) do { _Pragma("unroll") for (int n = 0; n < 2; ++n) _Pragma("unroll") for (int k = 0; k < 2; ++k) dst[n][k] = *(const PG8_LAS bf16x8*)(lds + PG8_SB(b, h) + boff + n * 2048 + k * 1024); } while (0)
#define PG8_MMA(ai, bj, At, Bt) do { __builtin_amdgcn_s_setprio(1); _Pragma("unroll") for (int m = 0; m < 4; ++m) _Pragma("unroll") for (int n = 0; n < 2; ++n) _Pragma("unroll") for (int k = 0; k < 2; ++k) \
        acc[ai][bj][m][n] = __builtin_amdgcn_mfma_f32_16x16x32_bf16(Bt[n][k], At[m][k], acc[ai][bj][m][n], 0, 0, 0); __builtin_amdgcn_s_setprio(0); } while (0)
#define PG8_WAIT_V(n) asm volatile("s_waitcnt vmcnt(" #n ")" ::: "memory")
#define PG8_WAIT_L(n) asm volatile("s_waitcnt lgkmcnt(" #n ")" ::: "memory")
#define PG8_BAR __builtin_amdgcn_s_barrier()
#define PG8_SCHED __builtin_amdgcn_sched_barrier(0)
    Unit cur, nxt; int ui = 0;
    if (!S.next(0, cur)) return;
    f32x4 acc[2][2][4][2];
#pragma unroll
    for (int a = 0; a < 2; ++a)
#pragma unroll
        for (int b = 0; b < 2; ++b)
#pragma unroll
            for (int m = 0; m < 4; ++m)
#pragma unroll
                for (int n = 0; n < 2; ++n) acc[a][b][m][n] = (f32x4){0.f, 0.f, 0.f, 0.f};
    bf16x8 At[4][2], B0[2][2], B1[2][2];
    const char* cA = (const char*)g.A + (size_t)cur.pm * tstep; const char* cB = (const char*)g.Bt + (size_t)cur.pn * tstep + (size_t)seq_of_pm(cur.pm) * g.bseq;
    S.a_ready(cur);
    PG8_STAGE(PG8_SB(0, 0), cB, voffB, Epi::B_AUX); PG8_STAGE(PG8_SA(0, 0), cA, voffA, Epi::A_AUX); PG8_STAGE(PG8_SB(0, 1), cB + hstep, voffB, Epi::B_AUX); PG8_STAGE(PG8_SA(0, 1), cA + hstep, voffA, Epi::A_AUX);
    if (wr == 1) PG8_BAR;
    PG8_WAIT_V(4); PG8_BAR;
    PG8_STAGE(PG8_SB(1, 0), cB + kstep, voffB, Epi::B_AUX); PG8_STAGE(PG8_SA(1, 0), cA + kstep, voffA, Epi::A_AUX); PG8_STAGE(PG8_SB(1, 1), cB + hstep + kstep, voffB, Epi::B_AUX);
    PG8_STAGE(PG8_SA(1, 1), cA + hstep + kstep, voffA, Epi::A_AUX);
    PG8_WAIT_V(8); PG8_BAR;
    for (;;) {
        const bool has_next = S.next(ui + 1, nxt);
        const char* nA = has_next ? (const char*)g.A + (size_t)nxt.pm * tstep : cA; const char* nB = has_next ? (const char*)g.Bt + (size_t)nxt.pn * tstep + (size_t)seq_of_pm(nxt.pm) * g.bseq : cB;
        for (int t = 0; t < nt; t += 2) {
            const bool last = (t == nt - 2);
            const char* a2 = last ? nA : cA + (size_t)(t + 2) * kstep; const char* b2 = last ? nB : cB + (size_t)(t + 2) * kstep;
            const char* a3 = a2 + kstep; const char* b3 = b2 + kstep;
            if (last && has_next) S.a_ready(nxt);
            PG8_LDB(B0, 0, 0); PG8_SCHED; PG8_LDA(At, 0, 0);
            PG8_WAIT_L(8); PG8_BAR; PG8_WAIT_L(0); PG8_MMA(0, 0, At, B0); PG8_BAR; PG8_SCHED;
            PG8_LDB(B1, 0, 1); PG8_STAGE(PG8_SB(0, 0), b2, voffB, Epi::B_AUX);
            PG8_BAR; PG8_WAIT_L(0); PG8_MMA(0, 1, At, B1); PG8_BAR;
            PG8_LDA(At, 0, 1); PG8_STAGE(PG8_SA(0, 0), a2, voffA, Epi::A_AUX);
            PG8_BAR; PG8_WAIT_L(0); PG8_MMA(1, 0, At, B0); PG8_BAR; PG8_SCHED;
            PG8_STAGE(PG8_SB(0, 1), b2 + hstep, voffB, Epi::B_AUX);
            { const int relax = __builtin_amdgcn_readfirstlane((t == 0 && ui > 0) ? 1 : 0);
              asm volatile("s_cmp_eq_u32 %0, 0\n\ts_cbranch_scc1 .Lpg8w6_%=\n\ts_waitcnt vmcnt(%1)\n\ts_branch .Lpg8wd_%=\n.Lpg8w6_%=:\n\ts_waitcnt vmcnt(6)\n.Lpg8wd_%=:" :: "s"(relax), "n"(6 + Epi::TAIL_STORES) : "scc", "memory"); }
            PG8_BAR; PG8_MMA(1, 1, At, B1); PG8_BAR;
            PG8_LDB(B0, 1, 0); PG8_SCHED; PG8_LDA(At, 1, 0); PG8_STAGE(PG8_SA(0, 1), a2 + hstep, voffA, Epi::A_AUX);
            PG8_WAIT_L(8); PG8_BAR; PG8_WAIT_L(0); PG8_MMA(0, 0, At, B0); PG8_BAR; PG8_SCHED;
            PG8_LDB(B1, 1, 1); PG8_STAGE(PG8_SB(1, 0), b3, voffB, Epi::B_AUX);
            PG8_BAR; PG8_WAIT_L(0); PG8_MMA(0, 1, At, B1); PG8_BAR;
            PG8_LDA(At, 1, 1); PG8_STAGE(PG8_SA(1, 0), a3, voffA, Epi::A_AUX);
            PG8_BAR; PG8_WAIT_L(0); PG8_MMA(1, 0, At, B0); PG8_BAR; PG8_SCHED;
            PG8_STAGE(PG8_SB(1, 1), b3 + hstep, voffB, Epi::B_AUX);
            PG8_WAIT_V(6); PG8_BAR; PG8_MMA(1, 1, At, B1); PG8_BAR;
            PG8_STAGE(PG8_SA(1, 1), a3 + hstep, voffA, Epi::A_AUX);
        }
        if constexpr (!Epi::AFTER_DRAIN) { E(acc, cur, wr, wc, fr, fq); S.done(cur); }
        if (!has_next) break;
#pragma unroll
        for (int a = 0; a < 2; ++a)
#pragma unroll
            for (int b = 0; b < 2; ++b)
#pragma unroll
                for (int m = 0; m < 4; ++m)
#pragma unroll
                    for (int n = 0; n < 2; ++n) acc[a][b][m][n] = (f32x4){0.f, 0.f, 0.f, 0.f};
        cur = nxt; cA = nA; cB = nB; ++ui;
    }
    PG8_WAIT_V(0);
    if (wr == 0) PG8_BAR;
    PG8_BAR;
    if constexpr (Epi::AFTER_DRAIN) { E.fused(acc, cur, wr, wc, fr, fq, lds, wid, lane); S.done(cur); }
#undef PG8_SA
#undef PG8_SB
#undef PG8_STAGE
#undef PG8_LDA
#undef PG8_LDB
#undef PG8_MMA
#undef PG8_WAIT_V
#undef PG8_WAIT_L
#undef PG8_BAR
#undef PG8_SCHED
}
}


using pg8::bf16_t; using pg8::bf16x8; using pg8::f32x4; using pg8::u32x4; using pg8::Unit;
typedef unsigned u32x2 __attribute__((ext_vector_type(2)));
#define LAS PG8_LAS
constexpr int T_TOK = 98304, T_P = 65536, DM = 1024, DFF = 2816;
constexpr int LDS_BYTES = 131072 + 16;
constexpr float EPSV = 1e-6f;

constexpr size_t WS_WAB_IN = 0;
constexpr size_t WS_WAB_OUT = WS_WAB_IN + (size_t)2560 * 1024 * 2;
constexpr size_t WS_WCD_IN = WS_WAB_OUT + (size_t)1024 * 1024 * 2;
constexpr size_t WS_WCD_OUT = WS_WCD_IN + (size_t)2048 * 1024 * 2;
constexpr size_t WS_WFFN_IN = WS_WCD_OUT + (size_t)1024 * 1024 * 2;
constexpr size_t WS_WFFN_OUT = WS_WFFN_IN + (size_t)2 * 5632 * 1024 * 2;
constexpr size_t WS_WS = WS_WFFN_OUT + (size_t)2 * 1024 * 2816 * 2;
constexpr size_t WS_MOD = WS_WS + (size_t)6 * 128 * 128 * 2;
constexpr size_t WS_DFT1 = WS_MOD + (size_t)2 * 10 * 6144 * 4;
constexpr size_t WS_DFT2A = WS_DFT1 + (size_t)256 * 256 * 2;
constexpr size_t WS_DFT2B = WS_DFT2A + (size_t)64 * 128 * 2;
constexpr size_t WS_H = WS_DFT2B + (size_t)128 * 256 * 2;
constexpr size_t WS_P = WS_H + (size_t)T_TOK * 1024 * 2;
constexpr size_t WS_Y1 = WS_P + (size_t)T_TOK * 2048 * 2;
constexpr size_t WS_RP = WS_P + (size_t)T_TOK * 2816 * 2;
constexpr size_t WS_BIAS = WS_RP + (size_t)4 * T_TOK * 16 * 4;
constexpr size_t WS_WF0 = WS_BIAS + (size_t)10 * (5632 + 2048 + 5632) * 4;
constexpr size_t WS_BAR = WS_WF0 + (size_t)10 * 5632 * 1024 * 2;
constexpr size_t WS_VP = WS_BAR + 16384;
constexpr size_t WS_END = WS_VP + (size_t)T_TOK * 12 * 8;
constexpr size_t DO_U = 0;
constexpr size_t DO_WCD = DO_U + (size_t)T_TOK * 1024 * 2;
constexpr size_t DO_WF1 = DO_WCD + (size_t)10 * 2048 * 1024 * 2;
constexpr size_t DO_END = DO_WF1 + (size_t)10 * 5632 * 1024 * 2;
static_assert(DO_END <= (size_t)T_TOK * 1024 * 4, "d_out scratch overflow");

#ifndef PROBE_SYNCS
#define PROBE_SYNCS 0
#endif
#ifndef PROBE_SG
#define PROBE_SG 0
#endif
#ifndef PROBE_HOT
#define PROBE_HOT 0
#endif
#ifndef PROBE_MASK
#define PROBE_MASK 0
#endif
struct Params { const float* in[24]; float* out; unsigned char* ws; int ph_lo, ph_hi; };

__device__ __forceinline__ int tid_opaque() { int t = threadIdx.x; asm volatile("" : "+v"(t)); return t; }
__device__ __forceinline__ int seq_of(int row) { return row < T_P ? (row >> 13) : 8 + ((row - T_P) >> 14); }
__device__ __forceinline__ float bf2f(unsigned short b) { return __uint_as_float(((unsigned)b) << 16); }
__device__ __forceinline__ unsigned pk2(float lo, float hi) { return pg8::cvt_pk_bf16(lo, hi); }
__device__ __forceinline__ float sigm(float x) { return __builtin_amdgcn_rcpf(1.0f + __builtin_amdgcn_exp2f(-1.44269504f * x)); }
__device__ __forceinline__ float wave_sum(float v) {
#pragma unroll
    for (int o = 32; o >= 1; o >>= 1) v += __shfl_xor(v, o);
    return v;
}

template <int KIND> struct EpiAct {
    static constexpr bool PERM = true, AFTER_DRAIN = false; static constexpr int A_AUX = 0, B_AUX = 0;
    static constexpr int TAIL_STORES = (KIND == 2) ? 16 : 8;
    bf16_t* O; int ldc; const float* rowpart; const float* bias; int nbias; float* vpart = nullptr;
    __device__ __forceinline__ void operator()(const f32x4 (&acc)[2][2][4][2], const Unit& u, int wr, int wc, int fr, int fq) const {
        asm volatile("" : "+v"(fr), "+v"(fq));
        const int row0 = u.pm * 256 + wr * 64 + fr;
        float rs[2][4]; f32x4 bv[2][2];
        if (rowpart) {
#pragma unroll
            for (int ai = 0; ai < 2; ++ai)
#pragma unroll
                for (int m = 0; m < 4; ++m) { const f32x4 pv = *(const f32x4*)(rowpart + (size_t)(row0 + ai * 128 + m * 16) * 16 + 4 * fq);
                    float ss = (pv[0] + pv[1]) + (pv[2] + pv[3]); ss += __shfl_xor(ss, 16); ss += __shfl_xor(ss, 32);
                    rs[ai][m] = __builtin_amdgcn_rsqf(ss * (1.0f / 1024.0f) + EPSV); }
            const float* bp = bias + (size_t)seq_of(u.pm * 256) * nbias + u.pn * 256 + wc * 32 + 8 * fq;
#pragma unroll
            for (int bj = 0; bj < 2; ++bj)
#pragma unroll
                for (int n = 0; n < 2; ++n) bv[bj][n] = *(const f32x4*)(bp + bj * 128 + 4 * n);
        } else {
#pragma unroll
            for (int ai = 0; ai < 2; ++ai)
#pragma unroll
                for (int m = 0; m < 4; ++m) rs[ai][m] = 1.0f;
#pragma unroll
            for (int bj = 0; bj < 2; ++bj)
#pragma unroll
                for (int n = 0; n < 2; ++n) bv[bj][n] = (f32x4){0.f, 0.f, 0.f, 0.f};
        }
        int mode, colbase;
        if (KIND == 2) { mode = 0; colbase = u.pn * 256; }
        else if (KIND == 1) { mode = 3; colbase = u.pn * 128; }
        else { if (u.pn < 2) { mode = 0; colbase = u.pn * 256; } else if (u.pn < 6) { mode = 1; colbase = 512 + (u.pn - 2) * 128; } else { mode = 2; colbase = 1024 + (u.pn - 6) * 128; } }
        const int col0 = colbase + wc * 32 + 8 * fq;
#pragma unroll
        for (int ai = 0; ai < 2; ++ai)
#pragma unroll
            for (int m = 0; m < 4; ++m) { bf16_t* rowp = O + (size_t)(row0 + ai * 128 + m * 16) * ldc + col0;
                const float sc = rs[ai][m];
                const f32x4 a0 = acc[ai][0][m][0] * sc + bv[0][0], a1 = acc[ai][0][m][1] * sc + bv[0][1], b0 = acc[ai][1][m][0] * sc + bv[1][0], b1 = acc[ai][1][m][1] * sc + bv[1][1];
                if (mode == 0) {
                    if (KIND == 2 && vpart != nullptr && u.pn >= 3 && u.pn < 6) {
                        float sv = ((a0[0] + a0[1]) + (a0[2] + a0[3])) + ((a1[0] + a1[1]) + (a1[2] + a1[3])) + ((b0[0] + b0[1]) + (b0[2] + b0[3])) + ((b1[0] + b1[1]) + (b1[2] + b1[3]));
                        float qv = ((a0[0] * a0[0] + a0[1] * a0[1]) + (a0[2] * a0[2] + a0[3] * a0[3])) + ((a1[0] * a1[0] + a1[1] * a1[1]) + (a1[2] * a1[2] + a1[3] * a1[3]))
                                 + ((b0[0] * b0[0] + b0[1] * b0[1]) + (b0[2] * b0[2] + b0[3] * b0[3])) + ((b1[0] * b1[0] + b1[1] * b1[1]) + (b1[2] * b1[2] + b1[3] * b1[3]));
                        sv += __shfl_xor(sv, 16); sv += __shfl_xor(sv, 32); qv += __shfl_xor(qv, 16); qv += __shfl_xor(qv, 32);
                        if (fq == 0) { float* vp = vpart + ((size_t)(row0 + ai * 128 + m * 16) * 12 + (u.pn - 3) * 4 + wc) * 2; vp[0] = sv; vp[1] = qv; }
                    }
                    u32x4 w; w.x = pk2(a0[0], a0[1]); w.y = pk2(a0[2], a0[3]); w.z = pk2(a1[0], a1[1]); w.w = pk2(a1[2], a1[3]);
                    __builtin_nontemporal_store(w, (u32x4*)rowp);
                    w.x = pk2(b0[0], b0[1]); w.y = pk2(b0[2], b0[3]); w.z = pk2(b1[0], b1[1]); w.w = pk2(b1[2], b1[3]);
                    __builtin_nontemporal_store(w, (u32x4*)(rowp + 128));
                } else {
                    float r[8];
#pragma unroll
                    for (int j = 0; j < 4; ++j) {
                        if (mode == 1) { r[j] = a0[j] * b0[j]; r[4 + j] = a1[j] * b1[j]; }
                        else if (mode == 2) { r[j] = a0[j] * sigm(b0[j]); r[4 + j] = a1[j] * sigm(b1[j]); }
                        else { r[j] = a0[j] * sigm(a0[j]) * b0[j]; r[4 + j] = a1[j] * sigm(a1[j]) * b1[j]; } }
                    u32x4 w; w.x = pk2(r[0], r[1]); w.y = pk2(r[2], r[3]); w.z = pk2(r[4], r[5]); w.w = pk2(r[6], r[7]);
                    __builtin_nontemporal_store(w, (u32x4*)rowp); }
            }
    }
};
#ifndef RES_A_AUX
#define RES_A_AUX 0
#endif
template <bool SRC_F32> struct EpiRes {
    static constexpr int TAIL_STORES = 8;
    static constexpr bool PERM = true, AFTER_DRAIN = false; static constexpr int A_AUX = RES_A_AUX, B_AUX = 0;
    const float* src0; const float* src1; bf16_t* X; const float* gate; float* rowpart;
    __device__ __forceinline__ void operator()(const f32x4 (&acc)[2][2][4][2], const Unit& u, int wr, int wc, int fr, int fq) const {
        asm volatile("" : "+v"(fr), "+v"(fq));
        const int rowl = wr * 64 + fr, col0 = u.pn * 256 + wc * 32 + 8 * fq, rbase = u.pm * 256;
        const int seq = seq_of(rbase);
        const float* gp = gate + (size_t)seq * 6144 + col0;
        f32x4 gv[2][2];
#pragma unroll
        for (int bj = 0; bj < 2; ++bj)
#pragma unroll
            for (int n = 0; n < 2; ++n) gv[bj][n] = *(const f32x4*)(gp + bj * 128 + 4 * n);
        bf16_t* xb = X + (size_t)rbase * 1024 + col0;
        const float* sb = (rbase < T_P) ? src0 + (size_t)rbase * 1024 + col0 : src1 + (size_t)(rbase - T_P) * 1024 + col0;
#pragma unroll
        for (int ai = 0; ai < 2; ++ai) {
            f32x4 sv[4][2][2];
            if (SRC_F32) {
#pragma unroll
                for (int m = 0; m < 4; ++m)
#pragma unroll
                    for (int bj = 0; bj < 2; ++bj)
#pragma unroll
                        for (int n = 0; n < 2; ++n) sv[m][bj][n] = *(const f32x4*)(sb + (size_t)(rowl + ai * 128 + m * 16) * 1024 + bj * 128 + 4 * n);
            } else {
                u32x4 raw[4][2];
#pragma unroll
                for (int m = 0; m < 4; ++m)
#pragma unroll
                    for (int bj = 0; bj < 2; ++bj) raw[m][bj] = *(const u32x4*)(xb + (size_t)(rowl + ai * 128 + m * 16) * 1024 + bj * 128);
#pragma unroll
                for (int m = 0; m < 4; ++m)
#pragma unroll
                    for (int bj = 0; bj < 2; ++bj) { const u32x4 r = raw[m][bj];
                        sv[m][bj][0] = (f32x4){__uint_as_float(r.x << 16), __uint_as_float(r.x & 0xffff0000u), __uint_as_float(r.y << 16), __uint_as_float(r.y & 0xffff0000u)};
                        sv[m][bj][1] = (f32x4){__uint_as_float(r.z << 16), __uint_as_float(r.z & 0xffff0000u), __uint_as_float(r.w << 16), __uint_as_float(r.w & 0xffff0000u)}; }
            }
#pragma unroll
            for (int m = 0; m < 4; ++m) { const int rl = rowl + ai * 128 + m * 16; float ss = 0.f;
#pragma unroll
                for (int bj = 0; bj < 2; ++bj) { const f32x4 x0 = sv[m][bj][0] + gv[bj][0] * acc[ai][bj][m][0], x1 = sv[m][bj][1] + gv[bj][1] * acc[ai][bj][m][1];
                    ss += (x0[0] * x0[0] + x0[1] * x0[1]) + (x0[2] * x0[2] + x0[3] * x0[3]) + (x1[0] * x1[0] + x1[1] * x1[1]) + (x1[2] * x1[2] + x1[3] * x1[3]);
                    u32x4 w; w.x = pk2(x0[0], x0[1]); w.y = pk2(x0[2], x0[3]); w.z = pk2(x1[0], x1[1]); w.w = pk2(x1[2], x1[3]);
                    *(u32x4*)(xb + (size_t)rl * 1024 + bj * 128) = w; }
                ss += __shfl_xor(ss, 16); ss += __shfl_xor(ss, 32);
                if (fq == 0) rowpart[(size_t)(rbase + rl) * 16 + u.pn * 4 + wc] = ss; }
            asm volatile("" ::: "memory");
        }
    }
};

__device__ __forceinline__ int map_ab(int n0) {
    if (n0 < 512) return n0;
    if (n0 < 1536) { const int q = (n0 - 512) >> 8, r = (n0 - 512) & 255; return r < 128 ? 512 + 128 * q + r : 1024 + 128 * q + (r - 128); }
    const int q = (n0 - 1536) >> 8, r = (n0 - 1536) & 255; return r < 128 ? 1536 + 128 * q + r : 2048 + 128 * q + (r - 128);
}
__device__ __forceinline__ int map_ffn(int n0) { const int q = n0 >> 8, r = n0 & 255; return r < 128 ? 128 * q + r : 2816 + 128 * q + (r - 128); }

__device__ __forceinline__ void tile_load(const float* __restrict__ src, int ld, int c0, int k0, float* tile) {
    const int tid = tid_opaque();
#pragma unroll
    for (int p = 0; p < 2; ++p) { const int r = (tid >> 4) + p * 32, c4 = (tid & 15) * 4;
        const f32x4 v = *(const f32x4*)(src + (size_t)(k0 + r) * ld + c0 + c4);
        float* t = tile + r * 65 + c4; t[0] = v[0]; t[1] = v[1]; t[2] = v[2]; t[3] = v[3]; }
}
__device__ __forceinline__ void tile_store_t(const float* tile, bf16_t* __restrict__ dst, int ldd, int n0, int k0) {
    const int tid = tid_opaque(), n = tid >> 3, k8 = (tid & 7) * 8;
    float f[8];
#pragma unroll
    for (int i = 0; i < 8; ++i) f[i] = tile[(k8 + i) * 65 + n];
    u32x4 w; w.x = pk2(f[0], f[1]); w.y = pk2(f[2], f[3]); w.z = pk2(f[4], f[5]); w.w = pk2(f[6], f[7]);
    *(u32x4*)(dst + (size_t)(n0 + n) * ldd + k0 + k8) = w;
}

__device__ void phase_prep(const Params& p, unsigned char* smem) {
    const int tid = tid_opaque(), lane = tid & 63, wave = tid >> 6, G = gridDim.x, bid = blockIdx.x;
    unsigned char* ws = p.ws;
    {
        float* sc = (float*)smem;
        float* red = sc + 10240;
        bool have = false;
        for (int task = bid; task < 192; task += G) {
            if (!have) { for (int i = tid; i < 10240; i += 512) { const float c = i < 8192 ? p.in[2][i] : p.in[3][i - 8192]; sc[i] = c * sigm(c); } have = true; }
            __syncthreads();
            const int l = task / 96, cb = task % 96, j = cb * 64 + lane;
            const float* W = p.in[4] + (size_t)l * 1024 * 6144 + j;
            float acc[10];
#pragma unroll
            for (int s = 0; s < 10; ++s) acc[s] = 0.f;
            const int kbeg = wave * 128;
#pragma unroll 8
            for (int k = 0; k < 128; ++k) { const float w = W[(size_t)(kbeg + k) * 6144];
#pragma unroll
                for (int s = 0; s < 10; ++s) acc[s] = fmaf(sc[s * 1024 + kbeg + k], w, acc[s]); }
#pragma unroll
            for (int s = 0; s < 10; ++s) red[(wave * 10 + s) * 64 + lane] = acc[s];
            __syncthreads();
            for (int i = tid; i < 640; i += 512) { const int s = i >> 6, ln = i & 63; float v = 0.f;
#pragma unroll
                for (int w = 0; w < 8; ++w) v += red[(w * 10 + s) * 64 + ln];
                const int jj = cb * 64 + ln; v += p.in[5][l * 6144 + jj];
                const int chunk = jj >> 10, d = jj & 1023;
                if (chunk == 1) v = p.in[6][l * 1024 + d] * (1.0f + v); else if (chunk == 4) v = p.in[7][l * 1024 + d] * (1.0f + v);
                ((float*)(ws + WS_MOD))[(size_t)(l * 10 + s) * 6144 + jj] = v; }
            __syncthreads();
        }
        __syncthreads();
    }
    {
        const int gt = bid * 512 + tid, gn = G * 512;
        bf16_t* wsb = (bf16_t*)(ws + WS_WS);
        for (int i = gt; i < 6 * 128 * 128 / 2; i += gn) ((unsigned*)wsb)[i] = pk2(p.in[18][2 * i], p.in[18][2 * i + 1]);
        bf16_t* d1 = (bf16_t*)(ws + WS_DFT1);
        for (int i = gt; i < 256 * 256 / 2; i += gn) { float v[2];
#pragma unroll
            for (int e = 0; e < 2; ++e) { const int idx = 2 * i + e, m = idx >> 8, k = idx & 255, po = m >> 7, ka = m & 127, pi = k >> 7, a = k & 127;
                const float rev = (float)((ka * a) & 127) * (1.0f / 128.0f); const float c = __builtin_amdgcn_cosf(rev), s = __builtin_amdgcn_sinf(rev);
                v[e] = po == 0 ? (pi == 0 ? c : -s) : (pi == 0 ? -s : -c); }
            ((unsigned*)d1)[i] = pk2(v[0], v[1]); }
        bf16_t* d2a = (bf16_t*)(ws + WS_DFT2A);
        for (int i = gt; i < 64 * 128 / 2; i += gn) { float v[2];
#pragma unroll
            for (int e = 0; e < 2; ++e) { const int idx = 2 * i + e, kb = idx >> 7, k = idx & 127, pi = k >> 6, b = k & 63;
                const float rev = (float)((kb * b) & 63) * (1.0f / 64.0f); v[e] = pi == 0 ? __builtin_amdgcn_cosf(rev) : __builtin_amdgcn_sinf(rev); }
            ((unsigned*)d2a)[i] = pk2(v[0], v[1]); }
        bf16_t* d2b = (bf16_t*)(ws + WS_DFT2B);
        for (int i = gt; i < 128 * 256 / 2; i += gn) { float v[2];
#pragma unroll
            for (int e = 0; e < 2; ++e) { const int idx = 2 * i + e, kb = idx >> 8, k = idx & 255, pi = k >> 7, b = k & 127;
                const float rev = (float)((kb * b) & 127) * (1.0f / 128.0f); v[e] = pi == 0 ? __builtin_amdgcn_cosf(rev) : __builtin_amdgcn_sinf(rev); }
            ((unsigned*)d2b)[i] = pk2(v[0], v[1]); }
    }
    {
        float* tile = (float*)smem;
        float* trig = tile + 64 * 65;
        if (tid < 64) { const float rev = (float)tid * (1.0f / 64.0f); trig[tid] = __builtin_amdgcn_cosf(rev); trig[64 + tid] = __builtin_amdgcn_sinf(rev); }
        __syncthreads();
        for (int id = bid; id < 5824; id += G) {
            const float* src; int ld, c0, k0, n0, ldd; bf16_t* dst; bool fold = false; int fg = 0;
            if (id < 640) { const int kt = id & 15, nt = id >> 4; src = p.in[8]; ld = 2560; k0 = kt * 64; n0 = nt * 64; c0 = map_ab(n0); dst = (bf16_t*)(ws + WS_WAB_IN); ldd = 1024; }
            else if (id < 896) { const int i2 = id - 640, kt = i2 & 15, nt = i2 >> 4; src = p.in[14]; ld = 1024; k0 = kt * 64; n0 = nt * 64; c0 = n0; dst = (bf16_t*)(ws + WS_WAB_OUT); ldd = 1024; }
            else if (id < 1280) { const int i2 = id - 896, kt = i2 & 15, nt = i2 >> 4; src = p.in[15]; ld = 1792; k0 = kt * 64; n0 = nt * 64; c0 = n0; dst = (bf16_t*)(ws + WS_WCD_IN); ldd = 1024; }
            else if (id < 1344) { const int i2 = id - 1280, kt = i2 & 15; fg = i2 >> 4; src = p.in[15]; ld = 1792; k0 = kt * 64; n0 = 0; c0 = 1536 + 64 * fg; dst = (bf16_t*)(ws + WS_WCD_IN); ldd = 1024; fold = true; }
            else if (id < 1600) { const int i2 = id - 1344, kt = i2 & 15, nt = i2 >> 4; src = p.in[20]; ld = 1024; k0 = kt * 64; n0 = nt * 64; c0 = n0; dst = (bf16_t*)(ws + WS_WCD_OUT); ldd = 1024; }
            else if (id < 4416) { const int i2 = id - 1600, l = i2 / 1408, i3 = i2 % 1408, kt = i3 & 15, nt = i3 >> 4; src = p.in[21] + (size_t)l * 1024 * 5632; ld = 5632; k0 = kt * 64; n0 = nt * 64; c0 = map_ffn(n0);
                dst = (bf16_t*)(ws + WS_WFFN_IN) + (size_t)l * 5632 * 1024; ldd = 1024; }
            else { const int i2 = id - 4416, l = i2 / 704, i3 = i2 % 704, kt = i3 % 44, nt = i3 / 44; src = p.in[22] + (size_t)l * 2816 * 1024; ld = 1024; k0 = kt * 64; n0 = nt * 64; c0 = n0;
                dst = (bf16_t*)(ws + WS_WFFN_OUT) + (size_t)l * 1024 * 2816; ldd = 2816; }
            tile_load(src, ld, c0, k0, tile);
            __syncthreads();
            if (!fold) tile_store_t(tile, dst, ldd, n0, k0);
            else {
                const int np = tid >> 2, part = np >> 6, k2 = np & 63, kq = tid & 3;
                const float* tr = trig + part * 64;
                float a[16];
#pragma unroll
                for (int i = 0; i < 16; ++i) a[i] = 0.f;
                for (int n2 = 0; n2 < 64; ++n2) { const float t = tr[(k2 * n2) & 63];
#pragma unroll
                    for (int i = 0; i < 16; ++i) a[i] = fmaf(tile[(kq * 16 + i) * 65 + n2], t, a[i]); }
                bf16_t* dp = dst + (size_t)(1536 + part * 256 + fg * 64 + k2) * 1024 + k0 + kq * 16;
                u32x4 w0, w1;
                w0.x = pk2(a[0], a[1]); w0.y = pk2(a[2], a[3]); w0.z = pk2(a[4], a[5]); w0.w = pk2(a[6], a[7]);
                w1.x = pk2(a[8], a[9]); w1.y = pk2(a[10], a[11]); w1.z = pk2(a[12], a[13]); w1.w = pk2(a[14], a[15]);
                *(u32x4*)dp = w0; *(u32x4*)(dp + 8) = w1;
            }
            __syncthreads();
        }
    }
}

__device__ void phase_norm(const float* src0, const float* src1, const float* modl, int chA, int chB, bf16_t* H) {
    const int tid = tid_opaque(), lane = tid & 63, wave = tid >> 6;
    const int nw = gridDim.x * 8;
    for (int row = blockIdx.x * 8 + wave; row < T_TOK; row += 2 * nw) {
        f32x4 v[2][4]; float ss[2];
#pragma unroll
        for (int r = 0; r < 2; ++r) { const int rr = (row + r * nw < T_TOK) ? row + r * nw : row;
            const float* xp = rr < T_P ? src0 + (size_t)rr * 1024 : src1 + (size_t)(rr - T_P) * 1024;
#pragma unroll
            for (int i = 0; i < 4; ++i) v[r][i] = *(const f32x4*)(xp + i * 256 + lane * 4); }
#pragma unroll
        for (int r = 0; r < 2; ++r) { float s = 0.f;
#pragma unroll
            for (int i = 0; i < 4; ++i) s += v[r][i][0] * v[r][i][0] + v[r][i][1] * v[r][i][1] + v[r][i][2] * v[r][i][2] + v[r][i][3] * v[r][i][3];
            ss[r] = wave_sum(s); }
#pragma unroll
        for (int r = 0; r < 2; ++r) { const int rr = row + r * nw; if (rr >= T_TOK) break;
            const float rstd = __builtin_amdgcn_rsqf(ss[r] * (1.0f / 1024.0f) + EPSV);
            const float* mp = modl + (size_t)seq_of(rr) * 6144;
#pragma unroll
            for (int i = 0; i < 4; ++i) { const f32x4 A = *(const f32x4*)(mp + chA * 1024 + i * 256 + lane * 4), B = *(const f32x4*)(mp + chB * 1024 + i * 256 + lane * 4);
                const f32x4 h = v[r][i] * rstd * A + B; u32x2 w; w.x = pk2(h[0], h[1]); w.y = pk2(h[2], h[3]);
                *(u32x2*)(H + (size_t)rr * 1024 + i * 256 + lane * 4) = w; } }
    }
}
__device__ void phase_final(float* out, const bf16_t* X, const float* rowpart, const float* g) {
    const int tid = tid_opaque(), lane = tid & 63, wave = tid >> 6;
    const int nw = gridDim.x * 8;
    f32x4 gv[4];
#pragma unroll
    for (int i = 0; i < 2; ++i) { gv[2 * i] = *(const f32x4*)(g + i * 512 + lane * 8); gv[2 * i + 1] = *(const f32x4*)(g + i * 512 + lane * 8 + 4); }
    for (int row = blockIdx.x * 8 + wave; row < T_TOK; row += 2 * nw) {
        u32x4 v[2][2]; f32x4 pp[2][4];
#pragma unroll
        for (int r = 0; r < 2; ++r) { const int rr = (row + r * nw < T_TOK) ? row + r * nw : row;
#pragma unroll
            for (int i = 0; i < 2; ++i) v[r][i] = *(const u32x4*)(X + (size_t)rr * 1024 + i * 512 + lane * 8);
#pragma unroll
            for (int i = 0; i < 4; ++i) pp[r][i] = *(const f32x4*)(rowpart + (size_t)rr * 16 + i * 4); }
#pragma unroll
        for (int r = 0; r < 2; ++r) { const int rr = row + r * nw; if (rr >= T_TOK) break;
            float ss = 0.f;
#pragma unroll
            for (int i = 0; i < 4; ++i) ss += (pp[r][i][0] + pp[r][i][1]) + (pp[r][i][2] + pp[r][i][3]);
            const float rstd = __builtin_amdgcn_rsqf(ss * (1.0f / 1024.0f) + EPSV);
            float* xp = out + (size_t)rr * 1024;
#pragma unroll
            for (int i = 0; i < 2; ++i) { const u32x4 q = v[r][i];
                const f32x4 a = (f32x4){__uint_as_float(q.x << 16), __uint_as_float(q.x & 0xffff0000u), __uint_as_float(q.y << 16), __uint_as_float(q.y & 0xffff0000u)};
                const f32x4 b = (f32x4){__uint_as_float(q.z << 16), __uint_as_float(q.z & 0xffff0000u), __uint_as_float(q.w << 16), __uint_as_float(q.w & 0xffff0000u)};
                *(f32x4*)(xp + i * 512 + lane * 8) = a * rstd * gv[2 * i]; *(f32x4*)(xp + i * 512 + lane * 8 + 4) = b * rstd * gv[2 * i + 1]; } }
    }
}
__device__ __forceinline__ void tile_store_scaled(const float* tile, bf16_t* __restrict__ dst, size_t seqstride, const float* __restrict__ avec, int n0, int k0) {
    const int tid = threadIdx.x, n = tid >> 3, k8 = (tid & 7) * 8;
    float f[8];
#pragma unroll
    for (int i = 0; i < 8; ++i) f[i] = tile[(k8 + i) * 65 + n];
#pragma unroll 2
    for (int sq = 0; sq < 10; ++sq) { const f32x4 a0 = *(const f32x4*)(avec + (size_t)sq * 6144 + k0 + k8), a1 = *(const f32x4*)(avec + (size_t)sq * 6144 + k0 + k8 + 4);
        u32x4 w; w.x = pk2(f[0] * a0[0], f[1] * a0[1]); w.y = pk2(f[2] * a0[2], f[3] * a0[3]); w.z = pk2(f[4] * a1[0], f[5] * a1[1]); w.w = pk2(f[6] * a1[2], f[7] * a1[3]);
        *(u32x4*)(dst + (size_t)sq * seqstride + (size_t)(n0 + n) * 1024 + k0 + k8) = w; }
}
__device__ void phase_wscaled(const Params& p, unsigned char* smem) {
    const int tid = tid_opaque();
    const float* mod = (const float*)(p.ws + WS_MOD);
    float* av = (float*)smem;
#pragma unroll 1
    for (int c = 0; c < 3; ++c) {
        const int N = (c == 1) ? 2048 : 5632;
        const float* avec = c == 0 ? mod + 4 * 1024 : c == 1 ? mod + 61440 + 1 * 1024 : mod + 61440 + 4 * 1024;
        const bf16_t* Bt = c == 0 ? (const bf16_t*)(p.ws + WS_WFFN_IN) : c == 1 ? (const bf16_t*)(p.ws + WS_WCD_IN) : (const bf16_t*)(p.ws + WS_WFFN_IN) + (size_t)5632 * 1024;
        bf16_t* dst = c == 0 ? (bf16_t*)(p.ws + WS_WF0) : c == 1 ? (bf16_t*)((unsigned char*)p.out + DO_WCD) : (bf16_t*)((unsigned char*)p.out + DO_WF1);
        const size_t sstr = (size_t)N * 1024;
        __syncthreads();
        for (int i = tid; i < 10240; i += 512) av[i] = avec[(size_t)(i >> 10) * 6144 + (i & 1023)];
        __syncthreads();
        const int nchunk = N * 128;
        for (int ch = blockIdx.x * 512 + tid; ch < nchunk; ch += gridDim.x * 512) {
            const int k8 = (ch & 127) * 8;
            const u32x4 wv = *(const u32x4*)(Bt + (size_t)ch * 8);
            float f[8];
#pragma unroll
            for (int e = 0; e < 4; ++e) { f[2 * e] = __uint_as_float(wv[e] << 16); f[2 * e + 1] = __uint_as_float(wv[e] & 0xffff0000u); }
#pragma unroll
            for (int sq = 0; sq < 10; ++sq) { const f32x4 a0 = *(const f32x4*)(av + sq * 1024 + k8), a1 = *(const f32x4*)(av + sq * 1024 + k8 + 4);
                u32x4 w; w.x = pk2(f[0] * a0[0], f[1] * a0[1]); w.y = pk2(f[2] * a0[2], f[3] * a0[3]); w.z = pk2(f[4] * a1[0], f[5] * a1[1]); w.w = pk2(f[6] * a1[2], f[7] * a1[3]);
                *(u32x4*)(dst + (size_t)sq * sstr + (size_t)ch * 8) = w; }
        }
    }
    __syncthreads();
}
__device__ void phase_bias(const Params& p, unsigned char* smem) {
    const int tid = tid_opaque(), lane = tid & 63, wave = tid >> 6, nw = gridDim.x * 8;
    float* sh = (float*)smem;
    const float* mod = (const float*)(p.ws + WS_MOD);
    float* biasb = (float*)(p.ws + WS_BIAS);
#pragma unroll 1
    for (int c = 0; c < 3; ++c) {
        const int N = (c == 1) ? 2048 : 5632;
        const float* shp = mod + (size_t)(c == 0 ? 0 : 1) * 61440 + (c == 1 ? 0 : 3) * 1024;
        const bf16_t* Bt = c == 0 ? (const bf16_t*)(p.ws + WS_WFFN_IN) : c == 1 ? (const bf16_t*)(p.ws + WS_WCD_IN) : (const bf16_t*)(p.ws + WS_WFFN_IN) + (size_t)5632 * 1024;
        float* bo = biasb + (c == 0 ? 0 : c == 1 ? 56320 : 56320 + 20480);
        __syncthreads();
        for (int i = tid; i < 10240; i += 512) sh[i] = shp[(size_t)(i >> 10) * 6144 + (i & 1023)];
        __syncthreads();
        for (int n = blockIdx.x * 8 + wave; n < N; n += nw) {
            const u32x4 w0 = *(const u32x4*)(Bt + (size_t)n * 1024 + lane * 16), w1 = *(const u32x4*)(Bt + (size_t)n * 1024 + lane * 16 + 8);
            float wf[16];
#pragma unroll
            for (int e = 0; e < 4; ++e) { wf[2 * e] = __uint_as_float(w0[e] << 16); wf[2 * e + 1] = __uint_as_float(w0[e] & 0xffff0000u); wf[8 + 2 * e] = __uint_as_float(w1[e] << 16); wf[8 + 2 * e + 1] = __uint_as_float(w1[e] & 0xffff0000u); }
            float my = 0.f;
#pragma unroll
            for (int sq = 0; sq < 10; ++sq) { float d = 0.f;
#pragma unroll
                for (int q = 0; q < 4; ++q) { const f32x4 b = *(const f32x4*)(sh + sq * 1024 + lane * 16 + q * 4); d += wf[q * 4] * b[0] + wf[q * 4 + 1] * b[1] + wf[q * 4 + 2] * b[2] + wf[q * 4 + 3] * b[3]; }
                d = wave_sum(d); if (lane == sq) my = d; }
            if (lane < 10) bo[(size_t)lane * N + n] = my;
        }
    }
    __syncthreads();
}

__device__ void phase_conv(const Params& p, unsigned char* smem) {
    const int tid = tid_opaque(), lane = tid & 63, wave = tid >> 6;
    const bf16_t* P0 = (const bf16_t*)(p.ws + WS_P);
    bf16_t* U = (bf16_t*)((unsigned char*)p.out + DO_U);
    bf16_t* gt = (bf16_t*)smem;
    float* zt = (float*)(smem + 94 * 1024);
    const float* wa = p.in[9];
    const float* wb = p.in[10];
    float w[31];
#pragma unroll
    for (int k = 0; k < 31; ++k) w[k] = wb[k * 512 + tid];
    const float bias = p.in[11][tid];
    float lg[8], lb[8];
#pragma unroll
    for (int i = 0; i < 8; ++i) { lg[i] = p.in[12][lane * 8 + i]; lb[i] = p.in[13][lane * 8 + i]; }
    const int ntiles = T_TOK / 64;
#define CONV_STAGE_LOAD(tile_, SG) do { const int t0_ = (tile_) * 64, seq_ = seq_of(t0_); \
        const int s0_ = seq_ < 8 ? seq_ * 8192 : T_P + (seq_ - 8) * 16384, s1_ = s0_ + (seq_ < 8 ? 8192 : 16384); \
        _Pragma("unroll") for (int j = 0; j < 12; ++j) { const int i = tid + 512 * j, r = i >> 6, ch = i & 63, tok = t0_ - 15 + r; \
            SG[j] = (u32x4){0u, 0u, 0u, 0u}; \
            if (i < 94 * 64 && tok >= s0_ && tok < s1_) SG[j] = *(const u32x4*)(P0 + (size_t)tok * 1536 + 1024 + ch * 8); } } while (0)
    u32x4 sg[12];
    if ((int)blockIdx.x < ntiles) CONV_STAGE_LOAD((int)blockIdx.x, sg);
    for (int tile = blockIdx.x; tile < ntiles; tile += gridDim.x) {
        const int t0 = tile * 64, seq = seq_of(t0);
        const int s0 = seq < 8 ? seq * 8192 : T_P + (seq - 8) * 16384, s1 = s0 + (seq < 8 ? 8192 : 16384);
#pragma unroll
        for (int j = 0; j < 12; ++j) { const int i = tid + 512 * j, r = i >> 6, ch = i & 63; if (i < 94 * 64) *(u32x4*)(gt + r * 512 + ch * 8) = sg[j]; }
        __syncthreads();
        if (tile + (int)gridDim.x < ntiles) CONV_STAGE_LOAD(tile + (int)gridDim.x, sg);
#pragma unroll 1
        for (int grp = 0; grp < 4; ++grp) {
            u32x4 yab[2], yx0[2], yxm[2], yxp[2];
#pragma unroll
            for (int j = 0; j < 2; ++j) { const int i = tid + 512 * j, t = grp * 16 + (i >> 6), ch = i & 63, tok = t0 + t, c0 = ch * 8;
                const bf16_t* rp = P0 + (size_t)tok * 1536;
                yab[j] = *(const u32x4*)(rp + c0); yx0[j] = *(const u32x4*)(rp + 512 + c0);
                yxm[j] = (u32x4){0u, 0u, 0u, 0u}; yxp[j] = (u32x4){0u, 0u, 0u, 0u};
                if (tok - 1 >= s0) yxm[j] = *(const u32x4*)(rp - 1536 + 512 + c0);
                if (tok + 1 < s1) yxp[j] = *(const u32x4*)(rp + 1536 + 512 + c0); }
            float g[46];
#pragma unroll
            for (int i = 0; i < 46; ++i) g[i] = bf2f(gt[(grp * 16 + i) * 512 + tid]);
#pragma unroll
            for (int t = 0; t < 16; ++t) { float a = bias;
#pragma unroll
                for (int k = 0; k < 31; ++k) a = fmaf(w[k], g[t + k], a);
                zt[t * 512 + tid] = a; }
            __syncthreads();
#pragma unroll
            for (int tt = 0; tt < 2; ++tt) { const int t = wave * 2 + tt;
                const f32x4 z0 = *(const f32x4*)(zt + t * 512 + lane * 8), z1 = *(const f32x4*)(zt + t * 512 + lane * 8 + 4);
                float s = (z0[0] + z0[1]) + (z0[2] + z0[3]) + (z1[0] + z1[1]) + (z1[2] + z1[3]);
                s = wave_sum(s); const float mu = s * (1.0f / 512.0f);
                const f32x4 d0 = z0 - mu, d1 = z1 - mu;
                float q = d0[0] * d0[0] + d0[1] * d0[1] + d0[2] * d0[2] + d0[3] * d0[3] + d1[0] * d1[0] + d1[1] * d1[1] + d1[2] * d1[2] + d1[3] * d1[3];
                q = wave_sum(q); const float rstd = __builtin_amdgcn_rsqf(q * (1.0f / 512.0f) + EPSV);
                float r[8];
#pragma unroll
                for (int e = 0; e < 8; ++e) { const float d = e < 4 ? d0[e & 3] : d1[e & 3]; const float y = d * rstd * lg[e] + lb[e]; r[e] = y * sigm(y); }
                u32x4 o; o.x = pk2(r[0], r[1]); o.y = pk2(r[2], r[3]); o.z = pk2(r[4], r[5]); o.w = pk2(r[6], r[7]);
                *(u32x4*)(U + (size_t)(t0 + grp * 16 + t) * 1024 + 512 + lane * 8) = o; }
#pragma unroll
            for (int j = 0; j < 2; ++j) { const int i = tid + 512 * j, t = grp * 16 + (i >> 6), ch = i & 63, tok = t0 + t, c0 = ch * 8;
                const u32x4 ab = yab[j], x0 = yx0[j], xm = yxm[j], xp = yxp[j];
                const f32x4 w0a = *(const f32x4*)(wa + c0), w0b = *(const f32x4*)(wa + c0 + 4), w1a = *(const f32x4*)(wa + 512 + c0), w1b = *(const f32x4*)(wa + 512 + c0 + 4),
                            w2a = *(const f32x4*)(wa + 1024 + c0), w2b = *(const f32x4*)(wa + 1024 + c0 + 4);
                float r[8];
#pragma unroll
                for (int e = 0; e < 8; ++e) { const unsigned sh = (e & 1) * 16; const int q = e >> 1;
                    const float fab = __uint_as_float((ab[q] >> sh) << 16), f0 = __uint_as_float((x0[q] >> sh) << 16), fm = __uint_as_float((xm[q] >> sh) << 16), fp = __uint_as_float((xp[q] >> sh) << 16);
                    const float k0 = e < 4 ? w0a[e & 3] : w0b[e & 3], k1 = e < 4 ? w1a[e & 3] : w1b[e & 3], k2 = e < 4 ? w2a[e & 3] : w2b[e & 3];
                    r[e] = fab * (k0 * fm + k1 * f0 + k2 * fp); }
                u32x4 o; o.x = pk2(r[0], r[1]); o.y = pk2(r[2], r[3]); o.z = pk2(r[4], r[5]); o.w = pk2(r[6], r[7]);
                *(u32x4*)(U + (size_t)tok * 1024 + c0) = o; }
            __syncthreads();
        }
    }
#undef CONV_STAGE_LOAD
}

__device__ void phase_sg(const Params& p, unsigned char* smem) {
    const int tid = tid_opaque(), lane = tid & 63, wave = tid >> 6, fr = lane & 15, fq = lane >> 4;
    const bf16_t* P1 = (const bf16_t*)(p.ws + WS_P);
    bf16_t* U = (bf16_t*)((unsigned char*)p.out + DO_U);
    const bf16_t* Wsb = (const bf16_t*)(p.ws + WS_WS);
    float* st = (float*)smem;
    bf16_t* vnT = (bf16_t*)(smem + 1024);
    constexpr int PITCH = 136;
    const int pp = wave * 16 + fr;
#define SG_LOAD(h_, WF, UU, BS, VA) do { \
        _Pragma("unroll") for (int kk = 0; kk < 4; ++kk) WF[kk] = *(const bf16x8*)(Wsb + (size_t)((h_) * 128 + pp) * 128 + kk * 32 + fq * 8); \
        _Pragma("unroll") for (int mt = 0; mt < 8; ++mt) UU[mt] = *(const u32x2*)(P1 + (size_t)(t0 + pp) * 2048 + (h_) * 128 + mt * 16 + 4 * fq); \
        BS = p.in[19][(h_) * 128 + pp]; \
        _Pragma("unroll") for (int j = 0; j < 4; ++j) { const int item = tid + 512 * j, q = item & 127, dc = item >> 7; VA[j] = *(const u32x4*)(P1 + (size_t)(t0 + q) * 2048 + 768 + (h_) * 128 + dc * 8); } \
    } while (0)
    for (int chunk = blockIdx.x; chunk < T_TOK / 128; chunk += gridDim.x) {
        const int t0 = chunk * 128;
        bf16x8 wfN[4]; u32x2 uuN[8]; float bsN; u32x4 vaN[4];
        SG_LOAD(0, wfN, uuN, bsN, vaN);
        if (tid < 128) { const float* vp = (const float*)(p.ws + WS_VP) + (size_t)(t0 + tid) * 24;
            float sv = 0.f, qv = 0.f;
#pragma unroll
            for (int i = 0; i < 6; ++i) { const f32x4 a = *(const f32x4*)(vp + 4 * i); sv += a[0] + a[2]; qv += a[1] + a[3]; }
            const float mu = sv * (1.0f / 768.0f); const float var = qv * (1.0f / 768.0f) - mu * mu;
            st[tid * 2] = mu; st[tid * 2 + 1] = __builtin_amdgcn_rsqf(fmaxf(var, 0.f) + EPSV); }
        __syncthreads();
#pragma unroll
        for (int h = 0; h < 6; ++h) {
            bf16x8 wf[4]; u32x2 uu[8]; u32x4 va[4]; const float bsv = bsN;
#pragma unroll
            for (int i = 0; i < 4; ++i) { wf[i] = wfN[i]; va[i] = vaN[i]; }
#pragma unroll
            for (int i = 0; i < 8; ++i) uu[i] = uuN[i];
#pragma unroll
            for (int j = 0; j < 4; ++j) { const int item = tid + 512 * j, q = item & 127, dc = item >> 7;
                const u32x4 a = va[j];
                const float mu = st[q * 2], rs = st[q * 2 + 1];
                const float* lg = p.in[16] + h * 128 + dc * 8; const float* lb = p.in[17] + h * 128 + dc * 8;
#pragma unroll
                for (int e = 0; e < 8; ++e) { const float x = (e & 1) ? __uint_as_float(a[e >> 1] & 0xffff0000u) : __uint_as_float(a[e >> 1] << 16);
                    const float y = (x - mu) * rs * lg[e] + lb[e];
                    vnT[(dc * 8 + e) * PITCH + q] = (bf16_t)(pk2(y, 0.f) & 0xffffu); } }
            __syncthreads();
            if (h < 5) SG_LOAD(h + 1, wfN, uuN, bsN, vaN);
            const size_t tokoff = (size_t)(t0 + pp);
#pragma unroll
            for (int mt = 0; mt < 8; ++mt) { f32x4 acc = (f32x4){0.f, 0.f, 0.f, 0.f};
#pragma unroll
                for (int kk = 0; kk < 4; ++kk) { const bf16x8 af = *(const bf16x8*)(vnT + (mt * 16 + fr) * PITCH + kk * 32 + fq * 8);
                    acc = __builtin_amdgcn_mfma_f32_16x16x32_bf16(af, wf[kk], acc, 0, 0, 0); }
                const int col = h * 128 + mt * 16 + 4 * fq;
                const u32x2 u2 = uu[mt];
                const float u0 = __uint_as_float(u2.x << 16), u1 = __uint_as_float(u2.x & 0xffff0000u), u2f = __uint_as_float(u2.y << 16), u3 = __uint_as_float(u2.y & 0xffff0000u);
                u32x2 o; o.x = pk2(u0 * (acc[0] + bsv), u1 * (acc[1] + bsv)); o.y = pk2(u2f * (acc[2] + bsv), u3 * (acc[3] + bsv));
                *(u32x2*)(U + tokoff * 1024 + col) = o; }
            __syncthreads();
        }
    }
#undef SG_LOAD
}

__device__ void phase_fft1(const Params& p, unsigned char* smem) {
    const int tid = tid_opaque(), lane = tid & 63, wave = tid >> 6, fr = lane & 15, fq = lane >> 4;
    const bf16_t* P1 = (const bf16_t*)(p.ws + WS_P);
    bf16_t* Y1 = (bf16_t*)(p.ws + WS_Y1);
    const bf16_t* D1 = (const bf16_t*)(p.ws + WS_DFT1);
    bf16_t* BT = (bf16_t*)smem;
    constexpr int PITCH = 264;
    bf16x8 af[2][8];
#pragma unroll
    for (int i = 0; i < 2; ++i)
#pragma unroll
        for (int kk = 0; kk < 8; ++kk) af[i][kk] = *(const bf16x8*)(D1 + (size_t)(i * 128 + wave * 16 + fr) * 256 + kk * 32 + fq * 8);
#define F1_DECODE(u_, seq_, b_, cblk_, N2_, tokbase_) do { int rem_; \
        if ((u_) < 2048) { seq_ = (u_) >> 8; rem_ = (u_) & 255; N2_ = 64; tokbase_ = seq_ * 8192; } else { const int u2_ = (u_) - 2048; seq_ = 8 + (u2_ >> 9); rem_ = u2_ & 511; N2_ = 128; tokbase_ = T_P + (seq_ - 8) * 16384; } \
        b_ = rem_ >> 2; cblk_ = rem_ & 3; } while (0)
#define F1_LOAD(u_, V) do { int seq_, b_, cblk_, N2_, tb_; F1_DECODE(u_, seq_, b_, cblk_, N2_, tb_); \
        _Pragma("unroll") for (int j = 0; j < 4; ++j) { const int item = tid + 512 * j, a = item & 127, rest = item >> 7, part = rest >> 3, ch8 = rest & 7; \
            V[j] = *(const u32x4*)(P1 + (size_t)(tb_ + a * N2_ + b_) * 2048 + 1536 + part * 256 + cblk_ * 64 + ch8 * 8); } } while (0)
    u32x4 nx[4];
    if ((int)blockIdx.x < 3072) F1_LOAD((int)blockIdx.x, nx);
    for (int u = blockIdx.x; u < 3072; u += gridDim.x) {
        int seq, b, cblk, N2, tokbase; F1_DECODE(u, seq, b, cblk, N2, tokbase);
#pragma unroll
        for (int j = 0; j < 4; ++j) { const int item = tid + 512 * j, a = item & 127, rest = item >> 7, part = rest >> 3, ch8 = rest & 7;
            const u32x4 v = nx[j];
#pragma unroll
            for (int e = 0; e < 8; ++e) BT[(ch8 * 8 + e) * PITCH + part * 128 + a] = (bf16_t)((e & 1) ? (v[e >> 1] >> 16) : (v[e >> 1] & 0xffffu)); }
        __syncthreads();
        if (u + (int)gridDim.x < 3072) F1_LOAD(u + (int)gridDim.x, nx);
        f32x4 acc[2][4];
#pragma unroll
        for (int i = 0; i < 2; ++i)
#pragma unroll
            for (int nt = 0; nt < 4; ++nt) acc[i][nt] = (f32x4){0.f, 0.f, 0.f, 0.f};
#pragma unroll
        for (int kk = 0; kk < 8; ++kk)
#pragma unroll
            for (int nt = 0; nt < 4; ++nt) { const bf16x8 bfr = *(const bf16x8*)(BT + (nt * 16 + fr) * PITCH + kk * 32 + fq * 8);
                acc[0][nt] = __builtin_amdgcn_mfma_f32_16x16x32_bf16(bfr, af[0][kk], acc[0][nt], 0, 0, 0);
                acc[1][nt] = __builtin_amdgcn_mfma_f32_16x16x32_bf16(bfr, af[1][kk], acc[1][nt], 0, 0, 0); }
        const int ka = wave * 16 + fr, S = N2 * 128;
        const float rev = (float)((ka * b) & (S - 1)) / (float)S; const float cw = __builtin_amdgcn_cosf(rev), sw = __builtin_amdgcn_sinf(rev);
        bf16_t* yp = Y1 + (size_t)(tokbase + ka * N2 + b) * 512 + cblk * 64 + 4 * fq;
#pragma unroll
        for (int nt = 0; nt < 4; ++nt) { const f32x4 yr = acc[0][nt], yi = acc[1][nt];
            const f32x4 zr = yr * cw + yi * sw, zi = yi * cw - yr * sw;
            u32x2 o; o.x = pk2(zr[0], zr[1]); o.y = pk2(zr[2], zr[3]); *(u32x2*)(yp + nt * 16) = o;
            o.x = pk2(zi[0], zi[1]); o.y = pk2(zi[2], zi[3]); *(u32x2*)(yp + 256 + nt * 16) = o; }
        __syncthreads();
    }
#undef F1_LOAD
#undef F1_DECODE
}
__device__ void phase_fft2(const Params& p, unsigned char* smem) {
    const int tid = tid_opaque(), lane = tid & 63, wave = tid >> 6, fr = lane & 15, fq = lane >> 4;
    const bf16_t* Y1 = (const bf16_t*)(p.ws + WS_Y1);
    bf16_t* U = (bf16_t*)((unsigned char*)p.out + DO_U);
    bf16_t* BT = (bf16_t*)smem;
    constexpr int PITCH = 264;
#define F2_DECODE(u_, N2_, lg2_, tokbase_, ka_, cblk_) do { \
        if ((u_) < 4096) { N2_ = 64; lg2_ = 6; tokbase_ = ((u_) >> 9) * 8192; } else { N2_ = 128; lg2_ = 7; tokbase_ = T_P + (((u_) - 4096) >> 9) * 16384; } \
        const int rem_ = (u_) & 511; ka_ = rem_ >> 2; cblk_ = rem_ & 3; } while (0)
#define F2_LOAD(u_, V) do { int N2_, lg2_, tb_, ka_, cblk_; F2_DECODE(u_, N2_, lg2_, tb_, ka_, cblk_); \
        _Pragma("unroll") for (int j = 0; j < 4; ++j) { const int item = tid + 512 * j; if (item < N2_ * 16) { const int b = item & (N2_ - 1), rest = item >> lg2_, part = rest >> 3, ch8 = rest & 7; \
            V[j] = *(const u32x4*)(Y1 + (size_t)(tb_ + ka_ * N2_ + b) * 512 + part * 256 + cblk_ * 64 + ch8 * 8); } } } while (0)
    u32x4 nx[4];
#pragma unroll
    for (int j = 0; j < 4; ++j) nx[j] = (u32x4){0u, 0u, 0u, 0u};
    if ((int)blockIdx.x < 5120) F2_LOAD((int)blockIdx.x, nx);
    for (int u = blockIdx.x; u < 5120; u += gridDim.x) {
        int N2, lg2, tokbase, ka, cblk; F2_DECODE(u, N2, lg2, tokbase, ka, cblk);
        const bf16_t* D2 = (N2 == 128) ? (const bf16_t*)(p.ws + WS_DFT2B) : (const bf16_t*)(p.ws + WS_DFT2A);
#pragma unroll
        for (int j = 0; j < 4; ++j) { const int item = tid + 512 * j; if (item < N2 * 16) { const int b = item & (N2 - 1), rest = item >> lg2, part = rest >> 3, ch8 = rest & 7;
            const u32x4 v = nx[j];
#pragma unroll
            for (int e = 0; e < 8; ++e) BT[(ch8 * 8 + e) * PITCH + part * N2 + b] = (bf16_t)((e & 1) ? (v[e >> 1] >> 16) : (v[e >> 1] & 0xffffu)); } }
        __syncthreads();
        if (u + (int)gridDim.x < 5120) F2_LOAD(u + (int)gridDim.x, nx);
        const int nb = (N2 == 128) ? wave : (wave & 3), mt0 = (N2 == 128) ? 0 : 2 * (wave >> 2), nmt = (N2 == 128) ? 4 : 2, ksteps = N2 >> 4, K2 = 2 * N2;
        f32x4 acc[4];
#pragma unroll
        for (int i = 0; i < 4; ++i) acc[i] = (f32x4){0.f, 0.f, 0.f, 0.f};
        for (int kk = 0; kk < ksteps; ++kk) { const bf16x8 df = *(const bf16x8*)(D2 + (size_t)(nb * 16 + fr) * K2 + kk * 32 + fq * 8);
#pragma unroll
            for (int i = 0; i < 4; ++i) if (i < nmt) { const bf16x8 bfr = *(const bf16x8*)(BT + ((mt0 + i) * 16 + fr) * PITCH + kk * 32 + fq * 8);
                acc[i] = __builtin_amdgcn_mfma_f32_16x16x32_bf16(bfr, df, acc[i], 0, 0, 0); } }
        const float scale = (N2 == 128) ? 9.765625e-4f : 1.3810679e-3f;
        const int kb = nb * 16 + fr;
        bf16_t* up = U + (size_t)(tokbase + ka + 128 * kb) * 1024 + 768 + cblk * 64 + 4 * fq;
#pragma unroll
        for (int i = 0; i < 4; ++i) if (i < nmt) { const f32x4 y = acc[i] * scale; u32x2 o; o.x = pk2(y[0], y[1]); o.y = pk2(y[2], y[3]); *(u32x2*)(up + (mt0 + i) * 16) = o; }
        __syncthreads();
    }
#undef F2_LOAD
#undef F2_DECODE
}

#define XB_TMO      128
#define XB_XCNT(j)  (256  + 64 * (j))
#define XB_XSUB(j)  (1280 + 64 * (j))
#define XB_XGEN(j)  (2304 + 64 * (j))
#define XB_TOP      3328
#define XB_TOPGEN   3392
#define XCD_BAR_WORDS 3456
#define XB_SPIN_CAP (1u << 22)
__device__ __forceinline__ unsigned xb_ld(unsigned* p)              { return __hip_atomic_load(p, __ATOMIC_RELAXED, __HIP_MEMORY_SCOPE_AGENT); }
__device__ __forceinline__ unsigned xb_add(unsigned* p, unsigned v) { return __hip_atomic_fetch_add(p, v, __ATOMIC_RELAXED, __HIP_MEMORY_SCOPE_AGENT); }
__device__ __forceinline__ unsigned xb_xcc_id() { return (unsigned)__builtin_amdgcn_s_getreg((3 << 11) | 20) & 0xFu; }
#define XB_SPIN(cond, bar) do { unsigned _sp = 0; while (cond) { __builtin_amdgcn_s_sleep(1); \
    if ((++_sp & 255u) == 0u) { if (xb_ld(&(bar)[XB_TMO])) break; if (_sp > XB_SPIN_CAP) { atomicAdd(&(bar)[XB_TMO], 1u); break; } } } } while (0)
struct XcdBarrier { unsigned* bar; unsigned x; volatile LAS unsigned* st; };
__device__ __forceinline__ XcdBarrier xcd_barrier_post(unsigned* bar, volatile LAS unsigned* st) {
    XcdBarrier b; b.bar = bar; b.x = xb_xcc_id(); b.st = st;
    if (threadIdx.x == 0) (void)xb_add(&bar[XB_XCNT(b.x)], 1u);
    return b;
}
__device__ __forceinline__ void xcd_barrier_complete(unsigned* bar, unsigned x, unsigned& nloc, unsigned& nx) {
    const unsigned G = gridDim.x * gridDim.y * gridDim.z;
    unsigned sum, cnt, mine, sp = 0u;
    for (;;) {
        sum = 0u; cnt = 0u; mine = 0u;
#pragma unroll
        for (unsigned j = 0; j < 16; ++j) { const unsigned c = xb_ld(&bar[XB_XCNT(j)]); sum += c; cnt += (c > 0u) ? 1u : 0u; mine = (j == x) ? c : mine; }
        if (sum == G) break;
        __builtin_amdgcn_s_sleep(1);
        if ((++sp & 255u) == 0u) { if (xb_ld(&bar[XB_TMO])) break; if (sp > XB_SPIN_CAP) { atomicAdd(&bar[XB_TMO], 1u); break; } }
    }
    nloc = mine > 0u ? mine : 1u; nx = cnt > 0u ? cnt : 1u;
}
__device__ __forceinline__ void xcd_barrier(const XcdBarrier& b) {
    asm volatile("s_waitcnt vmcnt(0)" ::: "memory");
    __syncthreads();
    if (threadIdx.x == 0) {
        unsigned* bar = b.bar;
        __builtin_amdgcn_s_waitcnt(0);
        unsigned nloc = b.st[0], nx = b.st[1];
        if (nloc == 0u) { xcd_barrier_complete(bar, b.x, nloc, nx); b.st[0] = nloc; b.st[1] = nx; }
        const unsigned old = xb_add(&bar[XB_XSUB(b.x)], 1u);
        const unsigned gen = old / nloc;
        if (old + 1u == (gen + 1u) * nloc) {
            __builtin_amdgcn_fence(__ATOMIC_RELEASE, "agent");
            asm volatile("s_waitcnt vmcnt(0)" ::: "memory");
            const unsigned og = xb_add(&bar[XB_TOP], 1u);
            const unsigned tg = og / nx;
            if (og + 1u == (tg + 1u) * nx) xb_add(&bar[XB_TOPGEN], 1u);
            else XB_SPIN(xb_ld(&bar[XB_TOPGEN]) == tg, bar);
            __builtin_amdgcn_fence(__ATOMIC_ACQUIRE, "agent");
            xb_add(&bar[XB_XGEN(b.x)], 1u);
            asm volatile("s_waitcnt vmcnt(0)" ::: "memory");
        } else {
            XB_SPIN(xb_ld(&bar[XB_XGEN(b.x)]) == gen, bar);
            __builtin_amdgcn_fence(__ATOMIC_ACQUIRE, "agent");
            asm volatile("s_waitcnt vmcnt(0)" ::: "memory");
        }
    }
    __syncthreads();
}

__device__ __forceinline__ int opaque(int v) { int r; asm volatile("s_mov_b32 %0, %1" : "=s"(r) : "s"(v)); return r; }
__global__ void __launch_bounds__(512, 2) fwd_mega(Params p) {
    extern __shared__ __attribute__((aligned(16))) unsigned char smem[];
    cg::grid_group grid = cg::this_grid();
    LAS unsigned char* lds = (LAS unsigned char*)smem;
    unsigned char* ws = p.ws;
    const int lo = p.ph_lo, hi = p.ph_hi, G = gridDim.x, bid = blockIdx.x;
    const float* mod = (const float*)(ws + WS_MOD);
    bf16_t* H = (bf16_t*)(ws + WS_H);
    bf16_t* P = (bf16_t*)(ws + WS_P);
    float* out = p.out;
    bf16_t* U = (bf16_t*)((unsigned char*)p.out + DO_U);
    bf16_t* X = H;
    float* rowpart = (float*)(ws + WS_RP);
    const float* biasb = (const float*)(ws + WS_BIAS);
    bool first = true;
    volatile LAS unsigned* xst = (volatile LAS unsigned*)(lds + 131072);
    if (threadIdx.x == 0) { xst[0] = 0u; xst[1] = 0u; }
    __syncthreads();
    XcdBarrier xbar = xcd_barrier_post((unsigned*)(ws + WS_BAR), xst);
    int nseam = 0;
#if PROBE_SYNCS
    for (int i = 0; i < PROBE_SYNCS; ++i) grid.sync();
#endif
#pragma unroll 1
    for (int ph = lo; ph < hi; ++ph) {
        if (ph == 5 || ph == 8 || ph == 13) continue;
#if PROBE_MASK
        for (int rep = 0; rep < (((PROBE_MASK >> ph) & 1) ? 2 : 1); ++rep) {
#endif
        if (!first) { if (hi > 1000) grid.sync(); else xcd_barrier(xbar); ++nseam; }
        first = false;
        const int l = ph >= 8 ? 1 : 0;
        const float* modl = mod + (size_t)l * 61440;
        if (ph == 0) phase_prep(p, smem);
        else if (ph == 1) { phase_wscaled(p, smem); phase_bias(p, smem); phase_norm(p.in[0], p.in[1], mod, 1, 0, H); }
        else if (ph == 2) { pg8::Gemm g{H, (const bf16_t*)(ws + WS_WAB_IN), T_TOK, opaque(2560), opaque(1024), 0}; pg8::StaticOrder S; S.init(T_TOK, g.N, G, bid);
            EpiAct<0> E{P, 1536, nullptr, nullptr, 0}; pg8::gemm_phase<EpiAct<0>, pg8::StaticOrder>(lds, g, S, E); }
#if PROBE_HOT
        else if (ph == 3) { { struct HotOrder : pg8::StaticOrder { __device__ bool next(int i, Unit& u) const { if (!pg8::StaticOrder::next(i, u)) return false; u.pm = 0; u.pn = u.pn % PROBE_HOT; return true; } };
            pg8::Gemm g{H, (const bf16_t*)(ws + WS_WAB_IN), T_TOK, opaque(2560), opaque(1024), 0}; HotOrder S; S.init(T_TOK, g.N, G, bid);
            EpiAct<2> E{(bf16_t*)(ws + WS_END), 2560, nullptr, nullptr, 0}; pg8::gemm_phase<EpiAct<2>, HotOrder>(lds, g, S, E); }
            grid.sync(); phase_conv(p, smem); }
#else
        else if (ph == 3) phase_conv(p, smem);
#endif
        else if (ph == 4) { pg8::Gemm g{U, (const bf16_t*)(ws + WS_WAB_OUT), T_TOK, opaque(1024), opaque(1024), 0}; pg8::StaticOrder S; S.init(T_TOK, g.N, G, bid);
            EpiRes<true> E{p.in[0], p.in[1], X, mod + 2 * 1024, rowpart}; pg8::gemm_phase<EpiRes<true>, pg8::StaticOrder>(lds, g, S, E); }
        else if (ph == 7 || ph == 12 || ph == 15) {
            const bool ffn = (ph != 12);
            const bf16_t* A = ffn ? P : U;
            const bf16_t* Bt = ph == 12 ? (const bf16_t*)(ws + WS_WCD_OUT) : (const bf16_t*)(ws + WS_WFFN_OUT) + (size_t)l * 1024 * 2816;
            pg8::Gemm g{A, Bt, T_TOK, opaque(1024), opaque(ffn ? DFF : 1024), 0}; pg8::StaticOrder S; S.init(T_TOK, g.N, G, bid);
            const int ri = ph == 7 ? 1 : ph == 12 ? 2 : 3;
            EpiRes<false> E{nullptr, nullptr, X, modl + (ffn ? 5 : 2) * 1024, rowpart + (size_t)ri * T_TOK * 16};
            pg8::gemm_phase<EpiRes<false>, pg8::StaticOrder>(lds, g, S, E);
        }
        else if (ph == 6 || ph == 14) { const bf16_t* Bt = l == 0 ? (const bf16_t*)(ws + WS_WF0) : (const bf16_t*)((unsigned char*)p.out + DO_WF1);
            pg8::Gemm g{X, Bt, T_TOK, opaque(5632), opaque(1024), (size_t)5632 * 1024 * 2}; pg8::StaticOrder S; S.init(T_TOK, g.N, G, bid);
            EpiAct<1> E{P, DFF, rowpart + (size_t)(l == 0 ? 0 : 2) * T_TOK * 16, biasb + (l == 0 ? 0 : 56320 + 20480), 5632}; pg8::gemm_phase<EpiAct<1>, pg8::StaticOrder>(lds, g, S, E); }
        else if (ph == 9) { pg8::Gemm g{X, (const bf16_t*)((unsigned char*)p.out + DO_WCD), T_TOK, opaque(2048), opaque(1024), (size_t)2048 * 1024 * 2}; pg8::StaticOrder S; S.init(T_TOK, g.N, G, bid);
            EpiAct<2> E{P, 2048, rowpart + (size_t)1 * T_TOK * 16, biasb + 56320, 2048}; E.vpart = (float*)(ws + WS_VP); pg8::gemm_phase<EpiAct<2>, pg8::StaticOrder>(lds, g, S, E); }
#if PROBE_SG
        else if (ph == 10) { phase_sg(p, smem); __syncthreads(); phase_sg(p, smem); __syncthreads(); phase_fft1(p, smem); }
#else
        else if (ph == 10) { phase_sg(p, smem); __syncthreads(); phase_fft1(p, smem); }
#endif
        else if (ph == 11) phase_fft2(p, smem);
        else if (ph == 16) phase_final(out, X, rowpart + (size_t)3 * T_TOK * 16, p.in[23]);
#if PROBE_MASK
        }
#endif
    }
}

#ifndef N_LAUNCH_SPLIT
#define N_LAUNCH_SPLIT 0
#endif
extern "C" void kernel_launch(void* const* d_in, const int* in_sizes, int n_in, void* d_out, int out_size, void* d_ws, size_t ws_size, hipStream_t stream) {
    static int grid = 0;
    if (grid == 0) {
        if (n_in != 24 || ws_size < WS_END) { fprintf(stderr, "kernel_launch: unexpected n_in %d or ws_size %zu (need %zu)\n", n_in, ws_size, (size_t)WS_END); grid = -1; return; }
        int dev = 0, cus = 0, per_cu = 0;
        hipGetDevice(&dev);
        hipDeviceGetAttribute(&cus, hipDeviceAttributeMultiprocessorCount, dev);
        if (hipFuncSetAttribute((const void*)fwd_mega, hipFuncAttributeMaxDynamicSharedMemorySize, LDS_BYTES) != hipSuccess) { fprintf(stderr, "kernel_launch: hipFuncSetAttribute failed\n"); grid = -1; return; }
        if (hipOccupancyMaxActiveBlocksPerMultiprocessor(&per_cu, (const void*)fwd_mega, 512, LDS_BYTES) != hipSuccess || per_cu < 1) { fprintf(stderr, "kernel_launch: occupancy query says %d\n", per_cu); per_cu = 1; }
        (void)hipGetLastError();
        grid = cus;
        if (grid > 256) grid = 256;
    }
    if (grid < 0) return;
    Params p{};
    for (int i = 0; i < 24; ++i) p.in[i] = (const float*)d_in[i];
    p.out = (float*)d_out; p.ws = (unsigned char*)d_ws;
#if N_LAUNCH_SPLIT
    for (int ph = 0; ph < 17; ++ph) { p.ph_lo = ph; p.ph_hi = ph + 1; void* args[] = {&p};
        hipError_t e = hipLaunchCooperativeKernel((const void*)fwd_mega, dim3(grid), dim3(512), args, LDS_BYTES, stream);
        if (e != hipSuccess) { fprintf(stderr, "cooperative launch failed: %s (grid %d)\n", hipGetErrorString(e), grid); break; } }
#else
    if (hipMemsetAsync((char*)d_ws + WS_BAR, 0, 16384, stream) != hipSuccess) { fprintf(stderr, "kernel_launch: memset of barrier words failed\n"); return; }
    p.ph_lo = 0; p.ph_hi = 17; void* args[] = {&p};
    hipError_t e = hipLaunchCooperativeKernel((const void*)fwd_mega, dim3(grid), dim3(512), args, LDS_BYTES, stream);
    if (e != hipSuccess) fprintf(stderr, "cooperative launch failed: %s (grid %d)\n", hipGetErrorString(e), grid);
#endif
}
```
